# Optimizing an MI355X kernel written in HIP

```python
import jax, jax.numpy as jnp
from jax import lax
import numpy as np

D_MODEL = 2048
BATCH = 1
SEQ = 8192
DEPTH = 1

N_MEM = 256
D_MIX = D_MODEL
ATTN_WIDTH = D_MIX // 2
SGU_WIDTH = D_MIX - ATTN_WIDTH
ATTN_HEAD_DIM = 64
N_ATTN_HEADS = ATTN_WIDTH // ATTN_HEAD_DIM
DILATED_BRANCHES = ((128, 1), (512, 4), (2048, 16))
BLOCK = 128
SGU_CHUNK = 128
SGU_GROUP_DIM = 128
N_SGU_GROUPS = SGU_WIDTH // SGU_GROUP_DIM
N_MEM_HEADS = 4
MEM_HEAD_DIM = D_MODEL // N_MEM_HEADS
D_FF = ((8 * D_MODEL // 3 + 255) // 256) * 256
D_IN = 3 * ATTN_WIDTH + 2 * SGU_WIDTH
ROPE_THETA = 10000.0
EPS = 1e-6
FFN_RES_SCALE = 0.5

kernel_name = "hybrid_dilated_attn_sgu_macaron_layer"


def _rmsnorm(x, g):
    x32 = x.astype(jnp.float32)
    y = x32 * lax.rsqrt(jnp.mean(x32 * x32, axis=-1, keepdims=True) + EPS)
    return (y * g.astype(jnp.float32)).astype(x.dtype)


def _layernorm(x, g, b):
    x32 = x.astype(jnp.float32)
    mu = jnp.mean(x32, axis=-1, keepdims=True)
    xc = x32 - mu
    y = xc * lax.rsqrt(jnp.mean(xc * xc, axis=-1, keepdims=True) + EPS)
    return (y * g.astype(jnp.float32) + b.astype(jnp.float32)).astype(x.dtype)


def _swiglu(x, w_gate, w_up, w_down):
    return (jax.nn.silu(x @ w_gate) * (x @ w_up)) @ w_down


def _rope(t, positions):
    e = t.shape[-1]
    inv_freq = ROPE_THETA ** (-jnp.arange(0, e, 2, dtype=jnp.float32) / e)
    ang = positions.astype(jnp.float32)[..., None] * inv_freq
    cos = jnp.cos(ang)[:, :, None, :]
    sin = jnp.sin(ang)[:, :, None, :]
    t32 = t.astype(jnp.float32)
    t1, t2 = t32[..., : e // 2], t32[..., e // 2:]
    return jnp.concatenate([t1 * cos - t2 * sin, t1 * sin + t2 * cos], axis=-1).astype(t.dtype)


def _dilated_branch(q, k, v, window, dilation):
    b, s, h, e = q.shape
    steps = window // dilation
    sub_len = s // dilation
    n_blk = -(-sub_len // BLOCK)
    pad = n_blk * BLOCK - sub_len

    def split(t):
        return t.reshape(b, sub_len, dilation, h, e).transpose(0, 2, 1, 3, 4)

    qs = jnp.pad(split(q), ((0, 0), (0, 0), (0, pad), (0, 0), (0, 0)))
    kv_pad = ((0, 0), (0, 0), (BLOCK, pad), (0, 0), (0, 0))
    ks = jnp.pad(split(k), kv_pad).reshape(b, dilation, n_blk + 1, BLOCK, h, e)
    vs = jnp.pad(split(v), kv_pad).reshape(b, dilation, n_blk + 1, BLOCK, h, e)
    qb = qs.reshape(b, dilation, n_blk, BLOCK, h, e)
    kb = jnp.concatenate([ks[:, :, :-1], ks[:, :, 1:]], axis=3)
    vb = jnp.concatenate([vs[:, :, :-1], vs[:, :, 1:]], axis=3)

    scores = jnp.einsum('brnqhe,brnkhe->brnhqk', qb, kb).astype(jnp.float32) * (e ** -0.5)
    qi = jnp.arange(BLOCK)[:, None]
    kj = jnp.arange(2 * BLOCK)[None, :]
    diff = qi + BLOCK - kj
    band = (diff >= 0) & (diff <= steps)
    blk = jnp.arange(n_blk)[:, None, None]
    valid = band[None] & ((blk > 0) | (kj[None] >= BLOCK))
    scores = jnp.where(valid[None, None, :, None], scores, -jnp.inf)
    m = jnp.max(scores, axis=-1, keepdims=True)
    p = jnp.exp(scores - m)
    l = jnp.sum(p, axis=-1, keepdims=True)
    o = jnp.einsum('brnhqk,brnkhe->brnqhe', (p / l).astype(v.dtype), vb)
    lse = (m + jnp.log(l))[..., 0]

    o = o.reshape(b, dilation, n_blk * BLOCK, h, e)[:, :, :sub_len]
    o = o.transpose(0, 2, 1, 3, 4).reshape(b, s, h, e)
    lse = lse.transpose(0, 1, 2, 4, 3).reshape(b, dilation, n_blk * BLOCK, h)[:, :, :sub_len]
    lse = lse.transpose(0, 2, 1, 3).reshape(b, s, h)
    return o, lse


def _dilated_attention(q, k, v):
    outs, lses = [], []
    for window, dilation in DILATED_BRANCHES:
        o, lse = _dilated_branch(q, k, v, window, dilation)
        outs.append(o)
        lses.append(lse)
    wts = jax.nn.softmax(jnp.stack(lses, axis=0), axis=0)
    return jnp.einsum('nbsh,nbshe->bshe', wts.astype(v.dtype), jnp.stack(outs, axis=0))


def _spatial_gating(u, gv, ln_g, ln_b, w_s, b_s):
    b, s, _ = gv.shape
    u = jax.nn.gelu(u)
    gv = _layernorm(jax.nn.gelu(gv), ln_g, ln_b)
    nc = s // SGU_CHUNK
    vc = gv.reshape(b, nc, SGU_CHUNK, N_SGU_GROUPS, SGU_GROUP_DIM)
    causal = jnp.tril(jnp.ones((SGU_CHUNK, SGU_CHUNK), dtype=bool))
    w = jnp.where(causal[None], w_s, 0.0).astype(gv.dtype)
    sv = jnp.einsum('gij,bcjgd->bcigd', w, vc) + b_s.T.astype(gv.dtype)[None, None, :, :, None]
    return u * sv.reshape(b, s, SGU_WIDTH)


def _token_mixing(h, positions, norm_g, w_in, ln_g, ln_b, w_s, b_s, attn_g, sgu_g, w_out):
    b, s, _ = h.shape
    xn = _rmsnorm(h, norm_g)
    proj = xn @ w_in
    q, k, v, u, gv = jnp.split(
        proj, [ATTN_WIDTH, 2 * ATTN_WIDTH, 3 * ATTN_WIDTH, 3 * ATTN_WIDTH + SGU_WIDTH], axis=-1)
    q = _rope(q.reshape(b, s, N_ATTN_HEADS, ATTN_HEAD_DIM), positions)
    k = _rope(k.reshape(b, s, N_ATTN_HEADS, ATTN_HEAD_DIM), positions)
    v = v.reshape(b, s, N_ATTN_HEADS, ATTN_HEAD_DIM)
    attn = _dilated_attention(q, k, v).reshape(b, s, ATTN_WIDTH)
    sgu = _spatial_gating(u, gv, ln_g, ln_b, w_s, b_s)
    mixed = jnp.concatenate([_rmsnorm(attn, attn_g), _rmsnorm(sgu, sgu_g)], axis=-1)
    return mixed @ w_out


def _memory_cross_attention(h, mem, g_q, g_kv, w_q, w_k, w_v, w_o):
    b, s, _ = h.shape
    n_mem = mem.shape[1]
    xq = _rmsnorm(h, g_q)
    mk = _rmsnorm(mem, g_kv)
    q = (xq @ w_q).reshape(b, s, N_MEM_HEADS, MEM_HEAD_DIM)
    k = (mk @ w_k).reshape(b, n_mem, N_MEM_HEADS, MEM_HEAD_DIM)
    v = (mk @ w_v).reshape(b, n_mem, N_MEM_HEADS, MEM_HEAD_DIM)
    scores = jnp.einsum('bshe,bmhe->bhsm', q, k).astype(jnp.float32) * (MEM_HEAD_DIM ** -0.5)
    p = jax.nn.softmax(scores, axis=-1).astype(v.dtype)
    o = jnp.einsum('bhsm,bmhe->bshe', p, v).reshape(b, s, D_MODEL)
    return o @ w_o


def setup_inputs(seed: int = 0) -> dict:
    key = jax.random.key(seed)
    ks = jax.random.split(key, 32)
    f32 = jnp.float32
    L = DEPTH

    def w(k, shape, fan_in):
        return jax.random.normal(k, shape, f32) * fan_in ** -0.5

    def gain(k, shape):
        return 1.0 + 0.01 * jax.random.normal(k, shape, f32)

    return {
        "x": jax.random.normal(ks[0], (BATCH, SEQ, D_MODEL), f32),
        "mem": jax.random.normal(ks[1], (BATCH, N_MEM, D_MODEL), f32),
        "positions": jnp.broadcast_to(jnp.arange(SEQ, dtype=jnp.int32), (BATCH, SEQ)),
        "ffn1_norm": gain(ks[2], (L, D_MODEL)),
        "ffn1_w_gate": w(ks[3], (L, D_MODEL, D_FF), D_MODEL),
        "ffn1_w_up": w(ks[4], (L, D_MODEL, D_FF), D_MODEL),
        "ffn1_w_down": w(ks[5], (L, D_FF, D_MODEL), D_FF),
        "mix_norm": gain(ks[6], (L, D_MODEL)),
        "w_in": w(ks[7], (L, D_MODEL, D_IN), D_MODEL),
        "sgu_ln_gain": gain(ks[8], (L, SGU_WIDTH)),
        "sgu_ln_bias": 0.01 * jax.random.normal(ks[9], (L, SGU_WIDTH), f32),
        "sgu_w_s": w(ks[10], (L, N_SGU_GROUPS, SGU_CHUNK, SGU_CHUNK), SGU_CHUNK),
        "sgu_b_s": 1.0 + 0.1 * jax.random.normal(ks[11], (L, N_SGU_GROUPS, SGU_CHUNK), f32),
        "attn_out_gain": gain(ks[12], (L, ATTN_WIDTH)),
        "sgu_out_gain": gain(ks[13], (L, SGU_WIDTH)),
        "w_out": w(ks[14], (L, D_MIX, D_MODEL), D_MIX),
        "mem_q_norm": gain(ks[15], (L, D_MODEL)),
        "mem_kv_norm": gain(ks[16], (L, D_MODEL)),
        "mem_w_q": w(ks[17], (L, D_MODEL, D_MODEL), D_MODEL),
        "mem_w_k": w(ks[18], (L, D_MODEL, D_MODEL), D_MODEL),
        "mem_w_v": w(ks[19], (L, D_MODEL, D_MODEL), D_MODEL),
        "mem_w_o": w(ks[20], (L, D_MODEL, D_MODEL), D_MODEL),
        "ffn2_norm": gain(ks[21], (L, D_MODEL)),
        "ffn2_w_gate": w(ks[22], (L, D_MODEL, D_FF), D_MODEL),
        "ffn2_w_up": w(ks[23], (L, D_MODEL, D_FF), D_MODEL),
        "ffn2_w_down": w(ks[24], (L, D_FF, D_MODEL), D_FF),
        "final_norm": gain(ks[25], (D_MODEL,)),
    }


def reference(x, mem, positions,
              ffn1_norm, ffn1_w_gate, ffn1_w_up, ffn1_w_down,
              mix_norm, w_in, sgu_ln_gain, sgu_ln_bias, sgu_w_s, sgu_b_s,
              attn_out_gain, sgu_out_gain, w_out,
              mem_q_norm, mem_kv_norm, mem_w_q, mem_w_k, mem_w_v, mem_w_o,
              ffn2_norm, ffn2_w_gate, ffn2_w_up, ffn2_w_down,
              final_norm):
    h = x
    for layer in range(DEPTH):
        h = h + FFN_RES_SCALE * _swiglu(_rmsnorm(h, ffn1_norm[layer]),
                                        ffn1_w_gate[layer], ffn1_w_up[layer], ffn1_w_down[layer])
        h = h + _token_mixing(h, positions, mix_norm[layer], w_in[layer],
                              sgu_ln_gain[layer], sgu_ln_bias[layer], sgu_w_s[layer], sgu_b_s[layer],
                              attn_out_gain[layer], sgu_out_gain[layer], w_out[layer])
        h = h + _memory_cross_attention(h, mem, mem_q_norm[layer], mem_kv_norm[layer],
                                        mem_w_q[layer], mem_w_k[layer], mem_w_v[layer], mem_w_o[layer])
        h = h + FFN_RES_SCALE * _swiglu(_rmsnorm(h, ffn2_norm[layer]),
                                        ffn2_w_gate[layer], ffn2_w_up[layer], ffn2_w_down[layer])
    return _rmsnorm(h, final_norm)
```

```cpp
#include <hip/hip_runtime.h>
#include <hip/hip_cooperative_groups.h>
#include <cstdio>
#include <cstdint>
#include <cmath>
namespace cg = cooperative_groups;
namespace pg8 {
#define PG8_LAS __attribute__((address_space(3)))
typedef unsigned short bf16_t;
typedef short bf16x8 __attribute__((ext_vector_type(8)));
typedef float f32x4 __attribute__((ext_vector_type(4)));
typedef unsigned u32x4 __attribute__((ext_vector_type(4)));
constexpr int BM = 256, BK = 64, HALF = 128, HTB = HALF * BK * 2  , STAGE_BYTES = 8 * HTB, NXCD = 8, WGM = 8;

__host__ __device__ __forceinline__ int lds_byte(int r, int c) { const int st = (r >> 4) * 2 + (c >> 5), rr = r & 15, cc = c & 31, ob = rr * 64 + cc * 2; return st * 1024 + (ob ^ (((ob >> 9) & 1) << 5)); }
__host__ __device__ __forceinline__ void stage_rc(int b, int& R, int& C) { const int st = b / 1024, sb = b % 1024, swz = sb ^ (((sb >> 9) & 1) << 5); R = (st >> 1) * 16 + swz / 64; C = (st & 1) * 32 + (swz % 64) / 2; }
__host__ __device__ __forceinline__ int perm32(int rho) { const int n = rho >> 4, i = rho & 15; return 8 * (i >> 2) + 4 * n + (i & 3); }

struct Unit { int pm, pn; };
struct Gemm { const bf16_t* A; const bf16_t* Bt; int M, N, K; };

struct StaticOrder {
    int nM, nN, nwg, G, c;
    __host__ __device__ void init(int M, int N, int G_, int c_) { nM = M / BM; nN = N / BM; nwg = nM * nN; G = G_; c = c_; }
    __host__ __device__ bool next(int i, Unit& u) const {
        const long L = (long)i * G + c; if (L >= nwg) return false;
        int wgid = (int)L; { const int q = nwg / NXCD, r = nwg % NXCD, xcd = wgid % NXCD, off = wgid / NXCD; wgid = (xcd < r ? xcd * (q + 1) : r * (q + 1) + (xcd - r) * q) + off; }
        const int nig = WGM * nN, gid = wgid / nig, fm = gid * WGM, gsz = (nM - fm) < WGM ? (nM - fm) : WGM;
        u.pm = fm + ((wgid % nig) % gsz); u.pn = (wgid % nig) / gsz; return true;
    }
    __device__ __forceinline__ void a_ready(const Unit&) const {}
    __device__ __forceinline__ void done(const Unit&) const {}
};

__device__ __forceinline__ unsigned cvt_pk_bf16(float lo, float hi) { unsigned r; asm volatile("v_cvt_pk_bf16_f32 %0, %1, %2" : "=v"(r) : "v"(lo), "v"(hi)); return r; }
typedef float f32x2 __attribute__((ext_vector_type(2)));
constexpr float NEPS = 1e-6f;
__device__ __forceinline__ float fast_sigmoid(float z) { return __builtin_amdgcn_rcpf(1.0f + __builtin_amdgcn_exp2f(-1.4426950408889634f * z)); }
__device__ __forceinline__ float silu_f(float x) { return x * fast_sigmoid(x); }
__device__ __forceinline__ float gelu_tanh_f(float x) { const float z = 1.5957691216057308f * (x + 0.044715f * x * x * x); return x * fast_sigmoid(z); }
__device__ __forceinline__ u32x4 pack8(const f32x4 a, const f32x4 b) { u32x4 w; w.x = cvt_pk_bf16(a[0], a[1]); w.y = cvt_pk_bf16(a[2], a[3]); w.z = cvt_pk_bf16(b[0], b[1]); w.w = cvt_pk_bf16(b[2], b[3]); return w; }

struct EpiSwiglu {
    static constexpr bool PERM = true, AFTER_DRAIN = false, MID = false;
    bf16_t* H; int ldh; const float* ss; float invw;
    __device__ __forceinline__ void operator()(const f32x4 (&acc)[2][2][4][2], const Unit& u, int wr, int wc, int fr, int fq) const {
        const int row0 = u.pm * BM + wr * 64 + fr, col0 = u.pn * HALF + wc * 32 + 8 * fq;
#pragma unroll
        for (int ai = 0; ai < 2; ++ai)
#pragma unroll
            for (int m = 0; m < 4; ++m) { const int r = row0 + ai * HALF + m * 16; const float rs = __builtin_amdgcn_rsqf(ss[r] * invw + NEPS);
                f32x4 h0, h1;
#pragma unroll
                for (int j = 0; j < 4; ++j) { h0[j] = silu_f(acc[ai][0][m][0][j] * rs) * (acc[ai][1][m][0][j] * rs); h1[j] = silu_f(acc[ai][0][m][1][j] * rs) * (acc[ai][1][m][1][j] * rs); }
                *(u32x4*)(H + (size_t)r * ldh + col0) = pack8(h0, h1); }
    }
};

template <bool HAS_MID> struct EpiResid {
    static constexpr bool PERM = true, AFTER_DRAIN = false, MID = HAS_MID;
    const float* base; float* out; bf16_t* xn; float* ss_out; const float* ss_in; float invw_in; float alpha; const float* ss_mid;
    __device__ __forceinline__ void mid(f32x4 (&acc)[2][2][4][2], const Unit& u, int wr, int fr) const {
        const int row0 = u.pm * BM + wr * 64 + fr;
#pragma unroll
        for (int ai = 0; ai < 2; ++ai)
#pragma unroll
            for (int m = 0; m < 4; ++m) { const int r = row0 + ai * HALF + m * 16;
                const float ratio = __builtin_amdgcn_rsqf(ss_mid[r] * invw_in + NEPS) * __builtin_sqrtf(ss_in[r] * invw_in + NEPS);
#pragma unroll
                for (int bj = 0; bj < 2; ++bj)
#pragma unroll
                    for (int n = 0; n < 2; ++n) acc[ai][bj][m][n] = acc[ai][bj][m][n] * ratio; }
    }
    __device__ __forceinline__ void operator()(const f32x4 (&acc)[2][2][4][2], const Unit& u, int wr, int wc, int fr, int fq) const {
        const int row0 = u.pm * BM + wr * 64 + fr, col0 = u.pn * BM + wc * 32 + 8 * fq;
#pragma unroll
        for (int ai = 0; ai < 2; ++ai)
#pragma unroll
            for (int m = 0; m < 4; ++m) { const int r = row0 + ai * HALF + m * 16;
                float sc = alpha; if (ss_in) sc *= __builtin_amdgcn_rsqf(ss_in[r] * invw_in + NEPS);
                float q = 0.f;
#pragma unroll
                for (int bj = 0; bj < 2; ++bj) { const size_t off = (size_t)r * 2048 + col0 + bj * HALF;
                    const f32x4 b0 = *(const f32x4*)(base + off), b1 = *(const f32x4*)(base + off + 4);
                    const f32x4 o0 = b0 + acc[ai][bj][m][0] * sc, o1 = b1 + acc[ai][bj][m][1] * sc;
                    *(f32x4*)(out + off) = o0; *(f32x4*)(out + off + 4) = o1;
                    q += (o0[0] * o0[0] + o0[1] * o0[1]) + (o0[2] * o0[2] + o0[3] * o0[3]) + (o1[0] * o1[0] + o1[1] * o1[1]) + (o1[2] * o1[2] + o1[3] * o1[3]);
                    if (xn) *(u32x4*)(xn + off) = pack8(o0, o1); }
                q += __shfl_xor(q, 16); q += __shfl_xor(q, 32);
                if (fq == 0) atomicAdd(ss_out + r, q); }
    }
};

struct EpiBf16Scale {
    static constexpr bool PERM = true, AFTER_DRAIN = false, MID = false;
    bf16_t* O; int ldc; const float* ss; float invw;
    __device__ __forceinline__ void operator()(const f32x4 (&acc)[2][2][4][2], const Unit& u, int wr, int wc, int fr, int fq) const {
        const int row0 = u.pm * BM + wr * 64 + fr, col0 = u.pn * BM + wc * 32 + 8 * fq;
#pragma unroll
        for (int ai = 0; ai < 2; ++ai)
#pragma unroll
            for (int m = 0; m < 4; ++m) { const int r = row0 + ai * HALF + m * 16; const float rs = ss ? __builtin_amdgcn_rsqf(ss[r] * invw + NEPS) : 1.0f;
#pragma unroll
                for (int bj = 0; bj < 2; ++bj) *(u32x4*)(O + (size_t)r * ldc + col0 + bj * HALF) = pack8(acc[ai][bj][m][0] * rs, acc[ai][bj][m][1] * rs); }
    }
};

struct EpiWin {
    static constexpr bool PERM = true, AFTER_DRAIN = false, MID = false;
    bf16_t* QKVUG; size_t rstride; const float* ss; float invw; const float* cosT; const float* sinT; float* ln_s1; float* ln_s2;
    __device__ __forceinline__ void operator()(const f32x4 (&acc)[2][2][4][2], const Unit& u, int wr, int wc, int fr, int fq) const {
        const int reg = u.pn >> 2, cc = (u.pn & 3) * BM, row0 = u.pm * BM + wr * 64 + fr;
        if (reg < 2) {
            bf16_t* O = QKVUG + (size_t)reg * rstride;
#pragma unroll
            for (int ai = 0; ai < 2; ++ai)
#pragma unroll
                for (int m = 0; m < 4; ++m) { const int r = row0 + ai * HALF + m * 16; const float rs = __builtin_amdgcn_rsqf(ss[r] * invw + NEPS);
                    const f32x4 c0 = *(const f32x4*)(cosT + (size_t)r * 32 + 8 * fq), c1 = *(const f32x4*)(cosT + (size_t)r * 32 + 8 * fq + 4);
                    const f32x4 s0 = *(const f32x4*)(sinT + (size_t)r * 32 + 8 * fq), s1 = *(const f32x4*)(sinT + (size_t)r * 32 + 8 * fq + 4);
                    const f32x4 a0 = acc[ai][0][m][0] * rs, a1 = acc[ai][0][m][1] * rs, b0 = acc[ai][1][m][0] * rs, b1 = acc[ai][1][m][1] * rs;
                    const f32x4 lo0 = a0 * c0 - b0 * s0, lo1 = a1 * c1 - b1 * s1, hi0 = a0 * s0 + b0 * c0, hi1 = a1 * s1 + b1 * c1;
                    bf16_t* p = O + (size_t)r * 1024 + cc + 64 * wc + 8 * fq;
                    *(u32x4*)p = pack8(lo0, lo1); *(u32x4*)(p + 32) = pack8(hi0, hi1); }
        } else {
            bf16_t* O = QKVUG + (size_t)reg * rstride;
#pragma unroll
            for (int ai = 0; ai < 2; ++ai)
#pragma unroll
                for (int m = 0; m < 4; ++m) { const int r = row0 + ai * HALF + m * 16; const float rs = __builtin_amdgcn_rsqf(ss[r] * invw + NEPS);
                    float s1 = 0.f, s2 = 0.f;
#pragma unroll
                    for (int bj = 0; bj < 2; ++bj) { f32x4 v0 = acc[ai][bj][m][0] * rs, v1 = acc[ai][bj][m][1] * rs;
                        if (reg >= 3) {
#pragma unroll
                            for (int j = 0; j < 4; ++j) { v0[j] = gelu_tanh_f(v0[j]); v1[j] = gelu_tanh_f(v1[j]); } }
                        if (reg == 4) { s1 += (v0[0] + v0[1]) + (v0[2] + v0[3]) + (v1[0] + v1[1]) + (v1[2] + v1[3]);
                            s2 += (v0[0] * v0[0] + v0[1] * v0[1]) + (v0[2] * v0[2] + v0[3] * v0[3]) + (v1[0] * v1[0] + v1[1] * v1[1]) + (v1[2] * v1[2] + v1[3] * v1[3]); }
                        *(u32x4*)(O + (size_t)r * 1024 + cc + bj * HALF + 32 * wc + 8 * fq) = pack8(v0, v1); }
                    if (reg == 4) { s1 += __shfl_xor(s1, 16); s1 += __shfl_xor(s1, 32); s2 += __shfl_xor(s2, 16); s2 += __shfl_xor(s2, 32);
                        if (fq == 0) { atomicAdd(ln_s1 + r, s1); atomicAdd(ln_s2 + r, s2); } } }
        }
    }
};
template <class Epi, class Sched, bool ALIGN_EPI = false, bool SP2 = false>
__device__ __forceinline__ void gemm_phase(PG8_LAS unsigned char* lds, const Gemm g, const Sched& S, const Epi& E) {
    const int tid = threadIdx.x, wid = __builtin_amdgcn_readfirstlane(tid >> 6), lane = tid & 63, wr = wid >> 2, wc = wid & 3, fr = lane & 15, fq = lane >> 4;
    const int K = g.K, nt = K / BK;
    unsigned voffA[2], voffB[2];
#pragma unroll
    for (int i = 0; i < 2; ++i) { int R, C; stage_rc(tid * 16 + i * 8192, R, C); const int Rb = Epi::PERM ? ((R & ~31) + perm32(R & 31)) : R;
        voffA[i] = (unsigned)(R * K + C) * 2u; voffB[i] = (unsigned)(Rb * K + C) * 2u; }
    const size_t kstep = (size_t)(BK * 2);
    const size_t hstep = (size_t)HALF * K * 2;
    const size_t tstep = 2 * hstep;
    const unsigned ldsw = (unsigned)wid * 1024u;
    const int aoff = lds_byte(wr * 64 + fr, fq * 8), boff = lds_byte(wc * 32 + fr, fq * 8);
#define PG8_SA(b, h) (((b) * 2 + (h)) * HTB)
#define PG8_SB(b, h) ((4 + (b) * 2 + (h)) * HTB)
#define PG8_STAGE(bufoff, gbase, voff) do { _Pragma("unroll") for (int _i = 0; _i < 2; ++_i) \
        __builtin_amdgcn_global_load_lds((const unsigned*)((const char*)(gbase) + (voff)[_i]), (PG8_LAS unsigned*)(lds + (bufoff) + ldsw + _i * 8192), 16, 0, 0); } while (0)
#define PG8_LDA(dst, b, h) do { _Pragma("unroll") for (int m = 0; m < 4; ++m) _Pragma("unroll") for (int k = 0; k < 2; ++k) dst[m][k] = *(const PG8_LAS bf16x8*)(lds + PG8_SA(b, h) + aoff + m * 2048 + k * 1024); } while (0)
#define PG8_LDB(dst, b, h) do { _Pragma("unroll") for (int n = 0; n < 2; ++n) _Pragma("unroll") for (int k = 0; k < 2; ++k) dst[n][k] = *(const PG8_LAS bf16x8*)(lds + PG8_SB(b, h) + boff + n * 2048 + k * 1024); } while (0)
#define PG8_MMA(ai, bj, At, Bt) do { __builtin_amdgcn_s_setprio(1); _Pragma("unroll") for (int m = 0; m < 4; ++m) _Pragma("unroll") for (int n = 0; n < 2; ++n) _Pragma("unroll") for (int k = 0; k < 2; ++k) \
        acc[ai][bj][m][n] = __builtin_amdgcn_mfma_f32_16x16x32_bf16(Bt[n][k], At[m][k], acc[ai][bj][m][n], 0, 0, 0); __builtin_amdgcn_s_setprio(0); } while (0)
#define PG8_WAIT_V(n) asm volatile("s_waitcnt vmcnt(" #n ")" ::: "memory")
#define PG8_WAIT_L(n) asm volatile("s_waitcnt lgkmcnt(" #n ")" ::: "memory")
#define PG8_BAR __builtin_amdgcn_s_barrier()
#define PG8_SCHED __builtin_amdgcn_sched_barrier(0)
    Unit cur, nxt; int ui = 0;
    if (!S.next(0, cur)) return;
    f32x4 acc[2][2][4][2];
#pragma unroll
    for (int a = 0; a < 2; ++a)
#pragma unroll
        for (int b = 0; b < 2; ++b)
#pragma unroll
            for (int m = 0; m < 4; ++m)
#pragma unroll
                for (int n = 0; n < 2; ++n) acc[a][b][m][n] = (f32x4){0.f, 0.f, 0.f, 0.f};
    bf16x8 At[4][2], B0[2][2], B1[2][2];
    const char* cA = (const char*)g.A + (size_t)cur.pm * tstep; const char* cB = (const char*)g.Bt + (size_t)cur.pn * tstep;
    S.a_ready(cur);
    if constexpr (SP2) {
        PG8_STAGE(PG8_SB(0, 0), cB, voffB); PG8_STAGE(PG8_SB(0, 1), cB + hstep, voffB); PG8_STAGE(PG8_SA(0, 0), cA, voffA); PG8_STAGE(PG8_SA(0, 1), cA + hstep, voffA);
        if (wr == 1) PG8_BAR;
        PG8_WAIT_V(2); PG8_BAR;
        PG8_STAGE(PG8_SB(1, 0), cB + kstep, voffB); PG8_STAGE(PG8_SA(1, 0), cA + kstep, voffA); PG8_STAGE(PG8_SB(1, 1), cB + hstep + kstep, voffB);
        PG8_WAIT_V(6); PG8_BAR;
    } else {
        PG8_STAGE(PG8_SB(0, 0), cB, voffB); PG8_STAGE(PG8_SA(0, 0), cA, voffA); PG8_STAGE(PG8_SB(0, 1), cB + hstep, voffB); PG8_STAGE(PG8_SA(0, 1), cA + hstep, voffA);
        if (wr == 1) PG8_BAR;
        PG8_WAIT_V(4); PG8_BAR;
        PG8_STAGE(PG8_SB(1, 0), cB + kstep, voffB); PG8_STAGE(PG8_SA(1, 0), cA + kstep, voffA); PG8_STAGE(PG8_SB(1, 1), cB + hstep + kstep, voffB);
        PG8_WAIT_V(6); PG8_BAR;
    }
    for (;;) {
        const bool has_next = S.next(ui + 1, nxt);
        const char* nA = has_next ? (const char*)g.A + (size_t)nxt.pm * tstep : cA; const char* nB = has_next ? (const char*)g.Bt + (size_t)nxt.pn * tstep : cB;
        for (int t = 0; t < nt; t += 2) {
            if constexpr (Epi::MID) { if (t == (nt >> 1)) E.mid(acc, cur, wr, fr); }
            const bool last = (t == nt - 2);
            const char* a1 = cA + (size_t)(t + 1) * kstep;
            const char* a2 = last ? nA : cA + (size_t)(t + 2) * kstep; const char* b2 = last ? nB : cB + (size_t)(t + 2) * kstep;
            const char* a3 = a2 + kstep; const char* b3 = b2 + kstep;
            if (last && has_next) S.a_ready(nxt);
            if constexpr (SP2) {
            PG8_LDB(B0, 0, 0); PG8_LDB(B1, 0, 1); PG8_SCHED; PG8_LDA(At, 0, 0); PG8_STAGE(PG8_SA(1, 1), a1 + hstep, voffA);
            PG8_WAIT_V(8); PG8_WAIT_L(0); PG8_BAR; PG8_MMA(0, 0, At, B0); PG8_MMA(0, 1, At, B1); PG8_BAR; PG8_SCHED;
            PG8_LDA(At, 0, 1); PG8_STAGE(PG8_SB(0, 0), b2, voffB); PG8_STAGE(PG8_SB(0, 1), b2 + hstep, voffB); PG8_STAGE(PG8_SA(0, 0), a2, voffA);
            PG8_WAIT_V(8); PG8_WAIT_L(0); PG8_BAR; PG8_MMA(1, 0, At, B0); PG8_MMA(1, 1, At, B1); PG8_BAR; PG8_SCHED;
            PG8_LDB(B0, 1, 0); PG8_LDB(B1, 1, 1); PG8_SCHED; PG8_LDA(At, 1, 0); PG8_STAGE(PG8_SA(0, 1), a2 + hstep, voffA);
            PG8_WAIT_V(8); PG8_WAIT_L(0); PG8_BAR; PG8_MMA(0, 0, At, B0); PG8_MMA(0, 1, At, B1); PG8_BAR; PG8_SCHED;
            PG8_LDA(At, 1, 1); PG8_STAGE(PG8_SB(1, 0), b3, voffB); PG8_STAGE(PG8_SB(1, 1), b3 + hstep, voffB); PG8_STAGE(PG8_SA(1, 0), a3, voffA);
            PG8_WAIT_V(8); PG8_WAIT_L(0); PG8_BAR; PG8_MMA(1, 0, At, B0); PG8_MMA(1, 1, At, B1); PG8_BAR; PG8_SCHED;
            } else {
            PG8_LDB(B0, 0, 0); PG8_SCHED; PG8_LDA(At, 0, 0); PG8_STAGE(PG8_SA(1, 1), a1 + hstep, voffA);
            PG8_WAIT_L(8); PG8_BAR; PG8_WAIT_L(0); PG8_MMA(0, 0, At, B0); PG8_BAR; PG8_SCHED;
            PG8_LDB(B1, 0, 1); PG8_STAGE(PG8_SB(0, 0), b2, voffB);
            PG8_BAR; PG8_WAIT_L(0); PG8_MMA(0, 1, At, B1); PG8_BAR;
            PG8_LDA(At, 0, 1); PG8_STAGE(PG8_SA(0, 0), a2, voffA);
            PG8_BAR; PG8_WAIT_L(0); PG8_MMA(1, 0, At, B0); PG8_BAR; PG8_SCHED;
            PG8_STAGE(PG8_SB(0, 1), b2 + hstep, voffB);
            PG8_WAIT_V(6); PG8_BAR; PG8_MMA(1, 1, At, B1); PG8_BAR;
            PG8_LDB(B0, 1, 0); PG8_SCHED; PG8_LDA(At, 1, 0); PG8_STAGE(PG8_SA(0, 1), a2 + hstep, voffA);
            PG8_WAIT_L(8); PG8_BAR; PG8_WAIT_L(0); PG8_MMA(0, 0, At, B0); PG8_BAR; PG8_SCHED;
            PG8_LDB(B1, 1, 1); PG8_STAGE(PG8_SB(1, 0), b3, voffB);
            PG8_BAR; PG8_WAIT_L(0); PG8_MMA(0, 1, At, B1); PG8_BAR;
            PG8_LDA(At, 1, 1); PG8_STAGE(PG8_SA(1, 0), a3, voffA);
            PG8_BAR; PG8_WAIT_L(0); PG8_MMA(1, 0, At, B0); PG8_BAR; PG8_SCHED;
            PG8_STAGE(PG8_SB(1, 1), b3 + hstep, voffB);
            PG8_WAIT_V(6); PG8_BAR; PG8_MMA(1, 1, At, B1); PG8_BAR;
            }
        }
        if constexpr (ALIGN_EPI) { if (wr == 0) PG8_BAR; }
        if constexpr (!Epi::AFTER_DRAIN) { E(acc, cur, wr, wc, fr, fq); S.done(cur); }
        if (!has_next) break;
#pragma unroll
        for (int a = 0; a < 2; ++a)
#pragma unroll
            for (int b = 0; b < 2; ++b)
#pragma unroll
                for (int m = 0; m < 4; ++m)
#pragma unroll
                    for (int n = 0; n < 2; ++n) acc[a][b][m][n] = (f32x4){0.f, 0.f, 0.f, 0.f};
        cur = nxt; cA = nA; cB = nB; ++ui;
        if constexpr (ALIGN_EPI) { if (wr == 1) PG8_BAR; }
    }
    PG8_WAIT_V(0);
    if constexpr (!ALIGN_EPI) { if (wr == 0) PG8_BAR; }
    PG8_BAR;
    if constexpr (Epi::AFTER_DRAIN) { E.fused(acc, cur, wr, wc, fr, fq, lds, wid, lane); S.done(cur); }
#undef PG8_SA
#undef PG8_SB
#undef PG8_STAGE
#undef PG8_LDA
#undef PG8_LDB
#undef PG8_MMA
#undef PG8_WAIT_V
#undef PG8_WAIT_L
#undef PG8_BAR
#undef PG8_SCHED
}
}

constexpr int NWAVES = 8;
constexpr int S_ = 8192, DM = 2048, DFF = 5632, NMEM = 256, DIN = 5120, AW = 1024;
constexpr size_t MiB = 1u << 20;
constexpr size_t WS_CTL = 0, WS_COS = 1 * MiB, WS_SIN = 2 * MiB, WS_MK = 3 * MiB, WS_KVM = 4 * MiB;
constexpr size_t WS_WGU1 = 6 * MiB, WS_WD1 = 50 * MiB, WS_WGU2 = 72 * MiB, WS_WD2 = 116 * MiB, WS_WIN = 138 * MiB, WS_WOUT = 158 * MiB, WS_WQ = 166 * MiB, WS_WKV = 174 * MiB, WS_WO = 190 * MiB;
constexpr size_t WS_XN = 198 * MiB, WS_MIXED = 230 * MiB, WS_OB = 262 * MiB, WS_LSE = 310 * MiB, WS_ACT = 312 * MiB, WS_END = 400 * MiB;
constexpr size_t WS_Q = WS_ACT, WS_K = WS_ACT + 16 * MiB, WS_V = WS_ACT + 32 * MiB, WS_U = WS_ACT + 48 * MiB, WS_GV = WS_ACT + 64 * MiB;
constexpr size_t WS_QM = WS_ACT, WS_OM = WS_ACT + 32 * MiB;
enum { SS_X = 0, SS_H1, LN_S1, LN_S2, SS_A, SS_S, SS_H2, SS_H3, SS_H4, SS_N };
constexpr int RING_BYTES = 131072, LDS_BYTES = 147456;

#define LAS __attribute__((address_space(3)))
typedef unsigned short bf16;
typedef unsigned v4u __attribute__((ext_vector_type(4)));
typedef unsigned v2u __attribute__((ext_vector_type(2)));
typedef float f32x4 __attribute__((ext_vector_type(4)));
typedef short bf16x8 __attribute__((ext_vector_type(8)));
#define LDS_WAIT() asm volatile("s_waitcnt lgkmcnt(0)" ::: "memory")
__device__ __forceinline__ unsigned f2bf(float f) { unsigned u = __builtin_bit_cast(unsigned, f); return (u + 0x7fffu + ((u >> 16) & 1u)) >> 16; }
__device__ __forceinline__ unsigned pk2(float lo, float hi) { return f2bf(lo) | (f2bf(hi) << 16); }
__device__ __forceinline__ float bf2f(unsigned short b) { return __uint_as_float((unsigned)b << 16); }
__device__ __forceinline__ float wave_sum(float v) {
#pragma unroll
    for (int o = 1; o < 64; o <<= 1) v += __shfl_xor(v, o);
    return v;
}
__device__ __forceinline__ float wave_max(float v) {
#pragma unroll
    for (int o = 1; o < 64; o <<= 1) v = fmaxf(v, __shfl_xor(v, o));
    return v;
}

__constant__ double INVF[32] = {1.0, 0.7498942093324559, 0.5623413251903491, 0.4216965034285822, 0.31622776601683794, 0.23713737056616552, 0.1778279410038923, 0.1333521432163324, 0.1, 0.07498942093324558, 0.05623413251903491, 0.042169650342858224, 0.03162277660168379, 0.023713737056616554, 0.01778279410038923, 0.01333521432163324, 0.01, 0.007498942093324558, 0.005623413251903491, 0.004216965034285823, 0.0031622776601683794, 0.0023713737056616554, 0.0017782794100389228, 0.001333521432163324, 0.001, 0.0007498942093324559, 0.0005623413251903491, 0.00042169650342858224, 0.00031622776601683794, 0.00023713737056616554, 0.00017782794100389227, 0.0001333521432163324};

struct Args { const void* in[27]; float* out; unsigned char* ws; int ph_lo, ph_hi; };

__device__ __forceinline__ void transpose_item(const float* W, int K, int N, const float* gain, bf16* WT, int k0, int n0, int dst_row0, LAS float* scr, int lane) {
#pragma unroll 8
    for (int i = 0; i < 32; ++i) { const int kk = 2 * i + (lane >> 5); float v = W[(size_t)(k0 + kk) * N + n0 + (lane & 31)]; if (gain) v *= gain[k0 + kk]; scr[kk * 33 + (lane & 31)] = v; }
    LDS_WAIT(); asm volatile("" ::: "memory");
    const int c = lane & 7;
#pragma unroll
    for (int j = 0; j < 4; ++j) { const int n = (lane >> 3) + 8 * j; const LAS float* s = scr + (8 * c) * 33 + n;
        v4u o; o.x = pk2(s[0 * 33], s[1 * 33]); o.y = pk2(s[2 * 33], s[3 * 33]); o.z = pk2(s[4 * 33], s[5 * 33]); o.w = pk2(s[6 * 33], s[7 * 33]);
        *(v4u*)(WT + (size_t)(dst_row0 + n) * K + k0 + 8 * c) = o; }
    LDS_WAIT(); asm volatile("" ::: "memory");
}
__device__ __forceinline__ void tr_job(const float* W, int K, int N, const float* g1, const float* g2, bf16* WT, int row_off, int mode, int item, LAS float* scr, int lane) {
    const int nblk = N / 32, kb = item / nblk, nb = item % nblk, k0 = 64 * kb, n0 = 32 * nb;
    const float* gain = g1; if (g2 && k0 >= 1024) gain = g2 - 1024;
    int dr = row_off + n0;
    if (mode == 1 || mode == 2) dr = (n0 >> 7) * 256 + (mode == 2 ? 128 : 0) + (n0 & 127);
    else if (mode == 3 && n0 < 2048) dr = (n0 >> 8) * 256 + ((n0 >> 5) & 1) * 128 + ((n0 >> 6) & 3) * 32;
    transpose_item(W, K, N, gain, WT, k0, n0, dr, scr, lane);
}

__device__ __forceinline__ void attn_naive(LAS unsigned char* lds, const bf16* Q, const bf16* K, const bf16* V, bf16* MIXED, float* ss_a, int gw, int NGW, int wave, int lane) {
    LAS float* qs = (LAS float*)lds + wave * 64;
    for (int wu = gw; wu < S_ * 16; wu += NGW) {
        const int t = wu >> 4, h = wu & 15;
        qs[lane] = bf2f(Q[(size_t)t * AW + h * 64 + lane]);
        LDS_WAIT(); asm volatile("" ::: "memory");
        float sc[9];
#pragma unroll
        for (int b = 0; b < 3; ++b)
#pragma unroll
            for (int p = 0; p < 3; ++p) {
                const int diff = 64 * p + lane, kt = t - (diff << (2 * b)); const bool valid = (diff <= 128) && (kt >= 0);
                float dot = 0.f;
                if (valid) { const bf16x8* kr = (const bf16x8*)(K + (size_t)kt * AW + h * 64);
#pragma unroll
                    for (int c = 0; c < 8; ++c) { const bf16x8 kv = kr[c];
#pragma unroll
                        for (int e = 0; e < 8; ++e) dot += qs[8 * c + e] * bf2f((unsigned short)kv[e]); } }
                sc[b * 3 + p] = valid ? dot * 0.125f : -INFINITY;
            }
        float m = sc[0];
#pragma unroll
        for (int i = 1; i < 9; ++i) m = fmaxf(m, sc[i]);
        m = wave_max(m);
        float l = 0.f;
#pragma unroll
        for (int i = 0; i < 9; ++i) { sc[i] = __expf(sc[i] - m); l += sc[i]; }
        l = wave_sum(l);
        float o = 0.f;
#pragma unroll
        for (int b = 0; b < 3; ++b)
#pragma unroll
            for (int p = 0; p < 3; ++p) {
                const int pbits = __float_as_int(sc[b * 3 + p]);
                for (int j = 0; j < 64; ++j) { const int diff = 64 * p + j, kt = t - (diff << (2 * b));
                    if (diff <= 128 && kt >= 0) { const float pj = __int_as_float(__builtin_amdgcn_readlane(pbits, j)); o += pj * bf2f(V[(size_t)kt * AW + h * 64 + lane]); } }
            }
        o = o / l;
        MIXED[(size_t)t * DM + h * 64 + lane] = (bf16)f2bf(o);
        const float q = wave_sum(o * o); if (lane == 0) atomicAdd(ss_a + t, q);
        asm volatile("" ::: "memory");
    }
}

__device__ __forceinline__ void sgu_naive(LAS unsigned char* lds, const bf16* U, const bf16* GV, const float* ln_s1, const float* ln_s2, const float* ln_g, const float* ln_b, const float* w_s, const float* b_s,
                                          bf16* MIXED, float* ss_s, int bx, int G, int tid, int lane) {
    LAS float* GT = (LAS float*)lds;
    LAS float* WL = (LAS float*)(lds + 65536);
    for (int unit = bx; unit < 64 * 8; unit += G) {
        const int c = unit >> 3, g = unit & 7;
        for (int idx = tid; idx < 128 * 128; idx += NWAVES * 64) {
            const int j = idx >> 7, d = idx & 127, tok = c * 128 + j, ch = g * 128 + d;
            const float mean = ln_s1[tok] * (1.0f / AW), var = ln_s2[tok] * (1.0f / AW) - mean * mean, rstd = 1.0f / sqrtf(var + 1e-6f);
            GT[idx] = (bf2f(GV[(size_t)tok * AW + ch]) - mean) * rstd * ln_g[ch] + ln_b[ch];
            WL[idx] = (d <= j) ? w_s[(size_t)g * 16384 + idx] : 0.f;
        }
        __syncthreads();
        const int d = tid & 127, iq = tid >> 7;
        for (int ii = 0; ii < 32; ++ii) {
            const int i = iq * 32 + ii; float acc = 0.f;
            for (int j = 0; j <= i; ++j) acc += WL[i * 128 + j] * GT[j * 128 + d];
            const int tok = c * 128 + i; const float sv = acc + b_s[g * 128 + i];
            const float o = bf2f(U[(size_t)tok * AW + g * 128 + d]) * sv;
            MIXED[(size_t)tok * DM + AW + g * 128 + d] = (bf16)f2bf(o);
            const float q = wave_sum(o * o); if (lane == 0) atomicAdd(ss_s + tok, q);
        }
        __syncthreads();
    }
}

__device__ __forceinline__ void xattn_naive(LAS unsigned char* lds, const bf16* QM, const bf16* KVM, bf16* OM, int gw, int NGW, int wave, int lane) {
    LAS float* qs = (LAS float*)lds + wave * 512;
    for (int wu = gw; wu < S_ * 4; wu += NGW) {
        const int t = wu >> 2, h = wu & 3;
        { const bf16x8 qv = *(const bf16x8*)(QM + (size_t)t * DM + h * 512 + lane * 8);
#pragma unroll
          for (int e = 0; e < 8; ++e) qs[lane * 8 + e] = bf2f((unsigned short)qv[e]); }
        LDS_WAIT(); asm volatile("" ::: "memory");
        float sc[4];
#pragma unroll
        for (int p = 0; p < 4; ++p) {
            const bf16x8* kr = (const bf16x8*)(KVM + (size_t)(64 * p + lane) * (2 * DM) + h * 512); float dot = 0.f;
            for (int c = 0; c < 64; ++c) { const bf16x8 kv = kr[c];
#pragma unroll
                for (int e = 0; e < 8; ++e) dot += qs[8 * c + e] * bf2f((unsigned short)kv[e]); }
            sc[p] = dot * 0.044194173824159216f;
        }
        float m = wave_max(fmaxf(fmaxf(sc[0], sc[1]), fmaxf(sc[2], sc[3])));
        float l = 0.f;
#pragma unroll
        for (int p = 0; p < 4; ++p) { sc[p] = __expf(sc[p] - m); l += sc[p]; }
        l = wave_sum(l);
        float o[8];
#pragma unroll
        for (int e = 0; e < 8; ++e) o[e] = 0.f;
#pragma unroll
        for (int p = 0; p < 4; ++p) { const int pbits = __float_as_int(sc[p]);
            for (int j = 0; j < 64; ++j) { const float pj = __int_as_float(__builtin_amdgcn_readlane(pbits, j));
                const bf16x8 vv = *(const bf16x8*)(KVM + (size_t)(64 * p + j) * (2 * DM) + DM + h * 512 + lane * 8);
#pragma unroll
                for (int e = 0; e < 8; ++e) o[e] += pj * bf2f((unsigned short)vv[e]); } }
        const float il = 1.0f / l;
        v4u w; w.x = pk2(o[0] * il, o[1] * il); w.y = pk2(o[2] * il, o[3] * il); w.z = pk2(o[4] * il, o[5] * il); w.w = pk2(o[6] * il, o[7] * il);
        *(v4u*)(OM + (size_t)t * DM + h * 512 + lane * 8) = w;
        asm volatile("" ::: "memory");
    }
}

__global__ void __launch_bounds__(NWAVES * 64, 2) mega_fwd(Args args) {
    extern __shared__ __attribute__((aligned(16))) unsigned char lds_raw[];
    LAS unsigned char* lds = (LAS unsigned char*)lds_raw;
    cg::grid_group grid = cg::this_grid();
    const int tid = threadIdx.x, lane = tid & 63, wave = __builtin_amdgcn_readfirstlane(tid >> 6);
    const int G = gridDim.x, bx = blockIdx.x;
    unsigned char* ws = args.ws;
    float* SS = (float*)(ws + WS_CTL);
    float* cosT = (float*)(ws + WS_COS); float* sinT = (float*)(ws + WS_SIN);
    bf16* MK = (bf16*)(ws + WS_MK); bf16* KVM = (bf16*)(ws + WS_KVM);
    bf16* WGU1 = (bf16*)(ws + WS_WGU1); bf16* WD1 = (bf16*)(ws + WS_WD1); bf16* WGU2 = (bf16*)(ws + WS_WGU2); bf16* WD2 = (bf16*)(ws + WS_WD2);
    bf16* WIN = (bf16*)(ws + WS_WIN); bf16* WOUT = (bf16*)(ws + WS_WOUT); bf16* WQ = (bf16*)(ws + WS_WQ); bf16* WKV = (bf16*)(ws + WS_WKV); bf16* WO = (bf16*)(ws + WS_WO);
    bf16* XN = (bf16*)(ws + WS_XN); bf16* MIXED = (bf16*)(ws + WS_MIXED); bf16* HB = (bf16*)(ws + WS_ACT);
    bf16* Qb = (bf16*)(ws + WS_Q); bf16* Kb = (bf16*)(ws + WS_K); bf16* Vb = (bf16*)(ws + WS_V); bf16* Ub = (bf16*)(ws + WS_U); bf16* GVb = (bf16*)(ws + WS_GV);
    bf16* QM = (bf16*)(ws + WS_QM); bf16* OM = (bf16*)(ws + WS_OM);
    const float* x = (const float*)args.in[0]; const float* mem = (const float*)args.in[1]; const int* positions = (const int*)args.in[2];
    float* HRES = args.out;
    const int lo = args.ph_lo, hi = args.ph_hi;
#ifndef PMASK
#define PMASK 0xFFFF
#endif
#define IN(k) (lo <= (k) && (k) < hi && ((PMASK >> (k)) & 1))
#define SEAM(k) do { if (IN(k) && IN((k) + 1)) grid.sync(); } while (0)
    const int gw = bx * NWAVES + wave, NGW = G * NWAVES;
    const int gt = bx * (NWAVES * 64) + tid, NGT = G * NWAVES * 64;

    if (IN(0)) {
        LAS float* scr = (LAS float*)(lds + wave * 16384);
#define INF(k) ((const float*)args.in[k])
        constexpr int I_GU = (DM / 64) * (DFF / 32), I_D = (DFF / 64) * (DM / 32), I_IN = (DM / 64) * (DIN / 32), I_SQ = (DM / 64) * (DM / 32);
        constexpr int NITEMS = 2 * (2 * I_GU + I_D) + I_IN + 5 * I_SQ;
        for (int it = gw; it < NITEMS; it += NGW) {
            int r = it;
            if (r < I_GU) { tr_job(INF(4), DM, DFF, INF(3), nullptr, WGU1, 0, 1, r, scr, lane); continue; } r -= I_GU;
            if (r < I_GU) { tr_job(INF(5), DM, DFF, INF(3), nullptr, WGU1, 0, 2, r, scr, lane); continue; } r -= I_GU;
            if (r < I_D) { tr_job(INF(6), DFF, DM, nullptr, nullptr, WD1, 0, 0, r, scr, lane); continue; } r -= I_D;
            if (r < I_GU) { tr_job(INF(23), DM, DFF, INF(22), nullptr, WGU2, 0, 1, r, scr, lane); continue; } r -= I_GU;
            if (r < I_GU) { tr_job(INF(24), DM, DFF, INF(22), nullptr, WGU2, 0, 2, r, scr, lane); continue; } r -= I_GU;
            if (r < I_D) { tr_job(INF(25), DFF, DM, nullptr, nullptr, WD2, 0, 0, r, scr, lane); continue; } r -= I_D;
            if (r < I_IN) { tr_job(INF(8), DM, DIN, INF(7), nullptr, WIN, 0, 3, r, scr, lane); continue; } r -= I_IN;
            if (r < I_SQ) { tr_job(INF(15), DM, DM, INF(13), INF(14), WOUT, 0, 0, r, scr, lane); continue; } r -= I_SQ;
            if (r < I_SQ) { tr_job(INF(18), DM, DM, INF(16), nullptr, WQ, 0, 0, r, scr, lane); continue; } r -= I_SQ;
            if (r < I_SQ) { tr_job(INF(19), DM, DM, nullptr, nullptr, WKV, 0, 0, r, scr, lane); continue; } r -= I_SQ;
            if (r < I_SQ) { tr_job(INF(20), DM, DM, nullptr, nullptr, WKV, 2048, 0, r, scr, lane); continue; } r -= I_SQ;
            tr_job(INF(21), DM, DM, nullptr, nullptr, WO, 0, 0, r, scr, lane);
        }
        for (int m = gw; m < S_; m += NGW) {
            const f32x4* xr = (const f32x4*)(x + (size_t)m * DM) + lane; float s = 0.f; v2u* o8 = (v2u*)(XN + (size_t)m * DM) + lane;
#pragma unroll
            for (int j = 0; j < 8; ++j) { const f32x4 v = xr[64 * j]; s += (v[0] * v[0] + v[1] * v[1]) + (v[2] * v[2] + v[3] * v[3]); v2u w; w.x = pk2(v[0], v[1]); w.y = pk2(v[2], v[3]); o8[64 * j] = w; }
            s = wave_sum(s); if (lane == 0) SS[SS_X * S_ + m] = s;
        }
        for (int m = gw; m < NMEM; m += NGW) {
            const f32x4* xr = (const f32x4*)(mem + (size_t)m * DM) + lane; const f32x4* gr = (const f32x4*)(INF(17)) + lane; float s = 0.f; f32x4 v[8];
#pragma unroll
            for (int j = 0; j < 8; ++j) { v[j] = xr[64 * j]; s += (v[j][0] * v[j][0] + v[j][1] * v[j][1]) + (v[j][2] * v[j][2] + v[j][3] * v[j][3]); }
            const float rs = 1.0f / sqrtf(wave_sum(s) * (1.0f / DM) + 1e-6f); v2u* o8 = (v2u*)(MK + (size_t)m * DM) + lane;
#pragma unroll
            for (int j = 0; j < 8; ++j) { const f32x4 g = gr[64 * j]; v2u w; w.x = pk2(v[j][0] * rs * g[0], v[j][1] * rs * g[1]); w.y = pk2(v[j][2] * rs * g[2], v[j][3] * rs * g[3]); o8[64 * j] = w; }
        }
        for (int i = gt; i < (SS_N - 1) * S_; i += NGT) SS[S_ + i] = 0.f;
        for (int i = gt; i < S_ * 32; i += NGT) {
            const int row = i >> 5, dd = i & 31; const double xx = (double)positions[row] * INVF[dd];
            const double kq = __builtin_rint(xx * 0.6366197723675814);
            double rr = __builtin_fma(-kq, 1.5707963267948966, xx); rr = __builtin_fma(-kq, 6.123233995736766e-17, rr);
            const int q = ((int)kq) & 3; const double r2 = rr * rr;
            double sn = -1.0 / 1307674368000.0; sn = sn * r2 + 1.0 / 6227020800.0; sn = sn * r2 - 1.0 / 39916800.0; sn = sn * r2 + 1.0 / 362880.0; sn = sn * r2 - 1.0 / 5040.0; sn = sn * r2 + 1.0 / 120.0; sn = sn * r2 - 1.0 / 6.0; sn = sn * r2 + 1.0; sn *= rr;
            double cs = 1.0 / 20922789888000.0; cs = cs * r2 - 1.0 / 87178291200.0; cs = cs * r2 + 1.0 / 479001600.0; cs = cs * r2 - 1.0 / 3628800.0; cs = cs * r2 + 1.0 / 40320.0; cs = cs * r2 - 1.0 / 720.0; cs = cs * r2 + 1.0 / 24.0; cs = cs * r2 - 0.5; cs = cs * r2 + 1.0;
            const double sv = (q == 0) ? sn : (q == 1) ? cs : (q == 2) ? -sn : -cs;
            const double cv = (q == 0) ? cs : (q == 1) ? -sn : (q == 2) ? -cs : sn;
            cosT[i] = (float)cv; sinT[i] = (float)sv;
        }
    }
    SEAM(0);

    if (IN(1)) {
        pg8::Gemm g{XN, WGU1, S_, 2 * DFF, DM}; pg8::StaticOrder S; S.init(S_, 2 * DFF, G, bx);
        pg8::EpiSwiglu E{HB, DFF, SS + SS_X * S_, 1.0f / DM};
        pg8::gemm_phase<pg8::EpiSwiglu, pg8::StaticOrder, true, true>(lds, g, S, E);
    }
    SEAM(1);
    if (IN(2)) {
        pg8::Gemm g{HB, WD1, S_, DM, DFF}; pg8::StaticOrder S; S.init(S_, DM, G, bx);
        pg8::EpiResid<false> E{x, HRES, XN, SS + SS_H1 * S_, nullptr, 0.f, 0.5f, nullptr};
        pg8::gemm_phase<pg8::EpiResid<false>, pg8::StaticOrder, true, true>(lds, g, S, E);
    }
    SEAM(2);
    if (IN(3)) {
        { pg8::Gemm g{XN, WIN, S_, DIN, DM}; pg8::StaticOrder S; S.init(S_, DIN, G, bx);
          pg8::EpiWin E{Qb, (size_t)(8u << 20), SS + SS_H1 * S_, 1.0f / DM, cosT, sinT, SS + LN_S1 * S_, SS + LN_S2 * S_};
          pg8::gemm_phase<pg8::EpiWin, pg8::StaticOrder, true, true>(lds, g, S, E); }
        { pg8::Gemm g{MK, WKV, NMEM, 2 * DM, DM}; pg8::StaticOrder S; S.init(NMEM, 2 * DM, G, (bx + G / 2) % G);
          pg8::EpiBf16Scale E{KVM, 2 * DM, nullptr, 0.f};
          pg8::gemm_phase<pg8::EpiBf16Scale, pg8::StaticOrder, true, true>(lds, g, S, E); }
    }
    SEAM(3);
    if (IN(4)) {
        attn_naive(lds, Qb, Kb, Vb, MIXED, SS + SS_A * S_, gw, NGW, wave, lane);
        __syncthreads();
        sgu_naive(lds, Ub, GVb, SS + LN_S1 * S_, SS + LN_S2 * S_, (const float*)args.in[9], (const float*)args.in[10], (const float*)args.in[11], (const float*)args.in[12], MIXED, SS + SS_S * S_, bx, G, tid, lane);
    }
    SEAM(4);
    if (IN(5)) {
        for (int m = gw; m < S_; m += NGW) {
            const float ra = 1.0f / sqrtf(SS[SS_A * S_ + m] * (1.0f / AW) + 1e-6f), rsg = 1.0f / sqrtf(SS[SS_S * S_ + m] * (1.0f / AW) + 1e-6f);
            v4u* p = (v4u*)(MIXED + (size_t)m * DM) + lane;
#pragma unroll
            for (int j = 0; j < 4; ++j) { v4u w = p[64 * j]; const float sc = j < 2 ? ra : rsg;
                w.x = pk2(bf2f((unsigned short)(w.x & 0xffff)) * sc, bf2f((unsigned short)(w.x >> 16)) * sc); w.y = pk2(bf2f((unsigned short)(w.y & 0xffff)) * sc, bf2f((unsigned short)(w.y >> 16)) * sc);
                w.z = pk2(bf2f((unsigned short)(w.z & 0xffff)) * sc, bf2f((unsigned short)(w.z >> 16)) * sc); w.w = pk2(bf2f((unsigned short)(w.w & 0xffff)) * sc, bf2f((unsigned short)(w.w >> 16)) * sc);
                p[64 * j] = w; }
        }
    }
    SEAM(5);
    if (IN(6)) {
        pg8::Gemm g{MIXED, WOUT, S_, DM, DM}; pg8::StaticOrder S; S.init(S_, DM, G, bx);
        pg8::EpiResid<false> E{HRES, HRES, XN, SS + SS_H2 * S_, nullptr, 0.f, 1.0f, nullptr};
        pg8::gemm_phase<pg8::EpiResid<false>, pg8::StaticOrder, true, true>(lds, g, S, E);
    }
    SEAM(6);
    if (IN(7)) {
        pg8::Gemm g{XN, WQ, S_, DM, DM}; pg8::StaticOrder S; S.init(S_, DM, G, bx);
        pg8::EpiBf16Scale E{QM, DM, SS + SS_H2 * S_, 1.0f / DM};
        pg8::gemm_phase<pg8::EpiBf16Scale, pg8::StaticOrder, true, true>(lds, g, S, E);
    }
    SEAM(7);
    if (IN(8)) { xattn_naive(lds, QM, KVM, OM, gw, NGW, wave, lane); }
    SEAM(8);
    if (IN(9)) {
        pg8::Gemm g{OM, WO, S_, DM, DM}; pg8::StaticOrder S; S.init(S_, DM, G, bx);
        pg8::EpiResid<false> E{HRES, HRES, XN, SS + SS_H3 * S_, nullptr, 0.f, 1.0f, nullptr};
        pg8::gemm_phase<pg8::EpiResid<false>, pg8::StaticOrder, true, true>(lds, g, S, E);
    }
    SEAM(9);
    if (IN(10)) {
        pg8::Gemm g{XN, WGU2, S_, 2 * DFF, DM}; pg8::StaticOrder S; S.init(S_, 2 * DFF, G, bx);
        pg8::EpiSwiglu E{HB, DFF, SS + SS_H3 * S_, 1.0f / DM};
        pg8::gemm_phase<pg8::EpiSwiglu, pg8::StaticOrder, true, true>(lds, g, S, E);
    }
    SEAM(10);
    if (IN(11)) {
        pg8::Gemm g{HB, WD2, S_, DM, DFF}; pg8::StaticOrder S; S.init(S_, DM, G, bx);
        pg8::EpiResid<false> E{HRES, HRES, nullptr, SS + SS_H4 * S_, nullptr, 0.f, 0.5f, nullptr};
        pg8::gemm_phase<pg8::EpiResid<false>, pg8::StaticOrder, true, true>(lds, g, S, E);
    }
    SEAM(11);
    if (IN(12)) {
        const float* fg = (const float*)args.in[26];
        for (int m = gw; m < S_; m += NGW) {
            f32x4* xr = (f32x4*)(HRES + (size_t)m * DM) + lane; const f32x4* gr = (const f32x4*)fg + lane;
            const float rs = 1.0f / sqrtf(SS[SS_H4 * S_ + m] * (1.0f / DM) + 1e-6f);
#pragma unroll
            for (int j = 0; j < 8; ++j) { f32x4 v = xr[64 * j]; const f32x4 g = gr[64 * j]; v = v * rs * g; xr[64 * j] = v; }
        }
    }
#undef IN
#undef SEAM
}

constexpr int NPH = 13;
extern "C" void kernel_launch(void* const* d_in, const int* in_sizes, int n_in, void* d_out, int out_size, void* d_ws, size_t ws_size, hipStream_t stream) {
    static int grid = 0;
    if (grid == 0) {
        if (n_in != 27 || out_size != S_ * DM || ws_size < WS_END) { fprintf(stderr, "kernel_launch: unexpected problem (n_in %d out %d ws %zu)\n", n_in, out_size, ws_size); grid = -1; return; }
        int dev = 0, cus = 0, per_cu = 0;
        hipGetDevice(&dev); hipDeviceGetAttribute(&cus, hipDeviceAttributeMultiprocessorCount, dev);
        hipFuncSetAttribute((const void*)mega_fwd, hipFuncAttributeMaxDynamicSharedMemorySize, LDS_BYTES);
        hipOccupancyMaxActiveBlocksPerMultiprocessor(&per_cu, (const void*)mega_fwd, NWAVES * 64, LDS_BYTES);
        if (per_cu < 1) per_cu = 1;
        (void)hipGetLastError();
        grid = cus * 1;
        fprintf(stderr, "kernel_launch: cus %d per_cu %d grid %d\n", cus, per_cu, grid);
    }
    if (grid < 0) return;
    Args a{};
    for (int i = 0; i < 27; ++i) a.in[i] = d_in[i];
    a.out = (float*)d_out; a.ws = (unsigned char*)d_ws; a.ph_lo = 0; a.ph_hi = NPH;
    void* kargs[] = {&a};
    hipError_t e = hipLaunchCooperativeKernel((const void*)mega_fwd, dim3(grid), dim3(NWAVES * 64), kargs, LDS_BYTES, stream);
    if (e != hipSuccess) fprintf(stderr, "cooperative launch failed: %s (grid %d)\n", hipGetErrorString(e), grid);
}
```

```cpp
#include <hip/hip_runtime.h>
#include <hip/hip_cooperative_groups.h>
#include <cstdio>
#include <cstdint>
#include <cmath>
namespace cg = cooperative_groups;
namespace pg8 {
#define PG8_LAS __attribute__((address_space(3)))
typedef unsigned short bf16_t;
typedef short bf16x8 __attribute__((ext_vector_type(8)));
typedef float f32x4 __attribute__((ext_vector_type(4)));
typedef unsigned u32x4 __attribute__((ext_vector_type(4)));
constexpr int BM = 256, BK = 64, HALF = 128, HTB = HALF * BK * 2  , STAGE_BYTES = 8 * HTB, NXCD = 8, WGM = 8;

__host__ __device__ __forceinline__ int lds_byte(int r, int c) { const int st = (r >> 4) * 2 + (c >> 5), rr = r & 15, cc = c & 31, ob = rr * 64 + cc * 2; return st * 1024 + (ob ^ (((ob >> 9) & 1) << 5)); }
__host__ __device__ __forceinline__ void stage_rc(int b, int& R, int& C) { const int st = b / 1024, sb = b % 1024, swz = sb ^ (((sb >> 9) & 1) << 5); R = (st >> 1) * 16 + swz / 64; C = (st & 1) * 32 + (swz % 64) / 2; }
__host__ __device__ __forceinline__ int perm32(int rho) { const int n = rho >> 4, i = rho & 15; return 8 * (i >> 2) + 4 * n + (i & 3); }

struct Unit { int pm, pn; };
struct Gemm { const bf16_t* A; const bf16_t* Bt; int M, N, K; };

struct StaticOrder {
    int nM, nN, nwg, G, c;
    __host__ __device__ void init(int M, int N, int G_, int c_) { nM = M / BM; nN = N / BM; nwg = nM * nN; G = G_; c = c_; }
    __host__ __device__ bool next(int i, Unit& u) const {
        const long L = (long)i * G + c; if (L >= nwg) return false;
        int wgid = (int)L; { const int q = nwg / NXCD, r = nwg % NXCD, xcd = wgid % NXCD, off = wgid / NXCD; wgid = (xcd < r ? xcd * (q + 1) : r * (q + 1) + (xcd - r) * q) + off; }
        const int nig = WGM * nN, gid = wgid / nig, fm = gid * WGM, gsz = (nM - fm) < WGM ? (nM - fm) : WGM;
        u.pm = fm + ((wgid % nig) % gsz); u.pn = (wgid % nig) / gsz; return true;
    }
    __device__ __forceinline__ void a_ready(const Unit&) const {}
    __device__ __forceinline__ void done(const Unit&) const {}
};

__device__ __forceinline__ unsigned cvt_pk_bf16(float lo, float hi) { unsigned r; asm volatile("v_cvt_pk_bf16_f32 %0, %1, %2" : "=v"(r) : "v"(lo), "v"(hi)); return r; }
typedef float f32x2 __attribute__((ext_vector_type(2)));
constexpr float NEPS = 1e-6f;
__device__ __forceinline__ float fast_sigmoid(float z) { return __builtin_amdgcn_rcpf(1.0f + __builtin_amdgcn_exp2f(-1.4426950408889634f * z)); }
__device__ __forceinline__ float silu_f(float x) { return x * fast_sigmoid(x); }
__device__ __forceinline__ float gelu_tanh_f(float x) { const float z = 1.5957691216057308f * (x + 0.044715f * x * x * x); return x * fast_sigmoid(z); }
__device__ __forceinline__ u32x4 pack8(const f32x4 a, const f32x4 b) { u32x4 w; w.x = cvt_pk_bf16(a[0], a[1]); w.y = cvt_pk_bf16(a[2], a[3]); w.z = cvt_pk_bf16(b[0], b[1]); w.w = cvt_pk_bf16(b[2], b[3]); return w; }

struct EpiSwiglu {
    static constexpr bool PERM = true, AFTER_DRAIN = false, MID = false;
    bf16_t* H; int ldh; const float* ss; float invw;
    __device__ __forceinline__ void operator()(const f32x4 (&acc)[2][2][4][2], const Unit& u, int wr, int wc, int fr, int fq) const {
        const int row0 = u.pm * BM + wr * 64 + fr, col0 = u.pn * HALF + wc * 32 + 8 * fq;
#pragma unroll
        for (int ai = 0; ai < 2; ++ai)
#pragma unroll
            for (int m = 0; m < 4; ++m) { const int r = row0 + ai * HALF + m * 16; const float rs = __builtin_amdgcn_rsqf(ss[r] * invw + NEPS);
                f32x4 h0, h1;
#pragma unroll
                for (int j = 0; j < 4; ++j) { h0[j] = silu_f(acc[ai][0][m][0][j] * rs) * (acc[ai][1][m][0][j] * rs); h1[j] = silu_f(acc[ai][0][m][1][j] * rs) * (acc[ai][1][m][1][j] * rs); }
                *(u32x4*)(H + (size_t)r * ldh + col0) = pack8(h0, h1); }
    }
};

template <bool HAS_MID> struct EpiResid {
    static constexpr bool PERM = true, AFTER_DRAIN = false, MID = HAS_MID;
    const float* base; float* out; bf16_t* xn; float* ss_out; const float* ss_in; float invw_in; float alpha; const float* ss_mid;
    __device__ __forceinline__ void mid(f32x4 (&acc)[2][2][4][2], const Unit& u, int wr, int fr) const {
        const int row0 = u.pm * BM + wr * 64 + fr;
#pragma unroll
        for (int ai = 0; ai < 2; ++ai)
#pragma unroll
            for (int m = 0; m < 4; ++m) { const int r = row0 + ai * HALF + m * 16;
                const float ratio = __builtin_amdgcn_rsqf(ss_mid[r] * invw_in + NEPS) * __builtin_sqrtf(ss_in[r] * invw_in + NEPS);
#pragma unroll
                for (int bj = 0; bj < 2; ++bj)
#pragma unroll
                    for (int n = 0; n < 2; ++n) acc[ai][bj][m][n] = acc[ai][bj][m][n] * ratio; }
    }
    __device__ __forceinline__ void operator()(const f32x4 (&acc)[2][2][4][2], const Unit& u, int wr, int wc, int fr, int fq) const {
        const int row0 = u.pm * BM + wr * 64 + fr, col0 = u.pn * BM + wc * 32 + 8 * fq;
#pragma unroll
        for (int ai = 0; ai < 2; ++ai)
#pragma unroll
            for (int m = 0; m < 4; ++m) { const int r = row0 + ai * HALF + m * 16;
                float sc = alpha; if (ss_in) sc *= __builtin_amdgcn_rsqf(ss_in[r] * invw_in + NEPS);
                float q = 0.f;
#pragma unroll
                for (int bj = 0; bj < 2; ++bj) { const size_t off = (size_t)r * 2048 + col0 + bj * HALF;
                    const f32x4 b0 = *(const f32x4*)(base + off), b1 = *(const f32x4*)(base + off + 4);
                    const f32x4 o0 = b0 + acc[ai][bj][m][0] * sc, o1 = b1 + acc[ai][bj][m][1] * sc;
                    *(f32x4*)(out + off) = o0; *(f32x4*)(out + off + 4) = o1;
                    q += (o0[0] * o0[0] + o0[1] * o0[1]) + (o0[2] * o0[2] + o0[3] * o0[3]) + (o1[0] * o1[0] + o1[1] * o1[1]) + (o1[2] * o1[2] + o1[3] * o1[3]);
                    if (xn) *(u32x4*)(xn + off) = pack8(o0, o1); }
                q += __shfl_xor(q, 16); q += __shfl_xor(q, 32);
                if (fq == 0) atomicAdd(ss_out + r, q); }
    }
};

struct EpiBf16Scale {
    static constexpr bool PERM = true, AFTER_DRAIN = false, MID = false;
    bf16_t* O; int ldc; const float* ss; float invw;
    __device__ __forceinline__ void operator()(const f32x4 (&acc)[2][2][4][2], const Unit& u, int wr, int wc, int fr, int fq) const {
        const int row0 = u.pm * BM + wr * 64 + fr, col0 = u.pn * BM + wc * 32 + 8 * fq;
#pragma unroll
        for (int ai = 0; ai < 2; ++ai)
#pragma unroll
            for (int m = 0; m < 4; ++m) { const int r = row0 + ai * HALF + m * 16; const float rs = ss ? __builtin_amdgcn_rsqf(ss[r] * invw + NEPS) : 1.0f;
#pragma unroll
                for (int bj = 0; bj < 2; ++bj) *(u32x4*)(O + (size_t)r * ldc + col0 + bj * HALF) = pack8(acc[ai][bj][m][0] * rs, acc[ai][bj][m][1] * rs); }
    }
};

struct EpiWin {
    static constexpr bool PERM = true, AFTER_DRAIN = false, MID = false;
    bf16_t* QKVUG; size_t rstride; const float* ss; float invw; const float* cosT; const float* sinT; float* ln_s1; float* ln_s2;
    __device__ __forceinline__ void operator()(const f32x4 (&acc)[2][2][4][2], const Unit& u, int wr, int wc, int fr, int fq) const {
        const int reg = u.pn >> 2, cc = (u.pn & 3) * BM, row0 = u.pm * BM + wr * 64 + fr;
        if (reg < 2) {
            bf16_t* O = QKVUG + (size_t)reg * rstride;
#pragma unroll
            for (int ai = 0; ai < 2; ++ai)
#pragma unroll
                for (int m = 0; m < 4; ++m) { const int r = row0 + ai * HALF + m * 16; const float rs = __builtin_amdgcn_rsqf(ss[r] * invw + NEPS);
                    const f32x4 c0 = *(const f32x4*)(cosT + (size_t)r * 32 + 8 * fq), c1 = *(const f32x4*)(cosT + (size_t)r * 32 + 8 * fq + 4);
                    const f32x4 s0 = *(const f32x4*)(sinT + (size_t)r * 32 + 8 * fq), s1 = *(const f32x4*)(sinT + (size_t)r * 32 + 8 * fq + 4);
                    const f32x4 a0 = acc[ai][0][m][0] * rs, a1 = acc[ai][0][m][1] * rs, b0 = acc[ai][1][m][0] * rs, b1 = acc[ai][1][m][1] * rs;
                    const f32x4 lo0 = a0 * c0 - b0 * s0, lo1 = a1 * c1 - b1 * s1, hi0 = a0 * s0 + b0 * c0, hi1 = a1 * s1 + b1 * c1;
                    bf16_t* p = O + (size_t)r * 1024 + cc + 64 * wc + 8 * fq;
                    *(u32x4*)p = pack8(lo0, lo1); *(u32x4*)(p + 32) = pack8(hi0, hi1); }
        } else {
            bf16_t* O = QKVUG + (size_t)reg * rstride;
#pragma unroll
            for (int ai = 0; ai < 2; ++ai)
#pragma unroll
                for (int m = 0; m < 4; ++m) { const int r = row0 + ai * HALF + m * 16; const float rs = __builtin_amdgcn_rsqf(ss[r] * invw + NEPS);
                    float s1 = 0.f, s2 = 0.f;
#pragma unroll
                    for (int bj = 0; bj < 2; ++bj) { f32x4 v0 = acc[ai][bj][m][0] * rs, v1 = acc[ai][bj][m][1] * rs;
                        if (reg >= 3) {
#pragma unroll
                            for (int j = 0; j < 4; ++j) { v0[j] = gelu_tanh_f(v0[j]); v1[j] = gelu_tanh_f(v1[j]); } }
                        if (reg == 4) { s1 += (v0[0] + v0[1]) + (v0[2] + v0[3]) + (v1[0] + v1[1]) + (v1[2] + v1[3]);
                            s2 += (v0[0] * v0[0] + v0[1] * v0[1]) + (v0[2] * v0[2] + v0[3] * v0[3]) + (v1[0] * v1[0] + v1[1] * v1[1]) + (v1[2] * v1[2] + v1[3] * v1[3]); }
                        *(u32x4*)(O + (size_t)r * 1024 + cc + bj * HALF + 32 * wc + 8 * fq) = pack8(v0, v1); }
                    if (reg == 4) { s1 += __shfl_xor(s1, 16); s1 += __shfl_xor(s1, 32); s2 += __shfl_xor(s2, 16); s2 += __shfl_xor(s2, 32);
                        if (fq == 0) { atomicAdd(ln_s1 + r, s1); atomicAdd(ln_s2 + r, s2); } } }
        }
    }
};
template <class Epi, class Sched, bool ALIGN_EPI = false, bool SP2 = false>
__device__ __forceinline__ void gemm_phase(PG8_LAS unsigned char* lds, const Gemm g, const Sched& S, const Epi& E) {
    const int tid = threadIdx.x, wid = __builtin_amdgcn_readfirstlane(tid >> 6), lane = tid & 63, wr = wid >> 2, wc = wid & 3, fr = lane & 15, fq = lane >> 4;
    const int K = g.K, nt = K / BK;
    unsigned voffA[2], voffB[2];
#pragma unroll
    for (int i = 0; i < 2; ++i) { int R, C; stage_rc(tid * 16 + i * 8192, R, C); const int Rb = Epi::PERM ? ((R & ~31) + perm32(R & 31)) : R;
        voffA[i] = (unsigned)(R * K + C) * 2u; voffB[i] = (unsigned)(Rb * K + C) * 2u; }
    const size_t kstep = (size_t)(BK * 2);
    const size_t hstep = (size_t)HALF * K * 2;
    const size_t tstep = 2 * hstep;
    const unsigned ldsw = (unsigned)wid * 1024u;
    const int aoff = lds_byte(wr * 64 + fr, fq * 8), boff = lds_byte(wc * 32 + fr, fq * 8);
#define PG8_SA(b, h) (((b) * 2 + (h)) * HTB)
#define PG8_SB(b, h) ((4 + (b) * 2 + (h)) * HTB)
#define PG8_STAGE(bufoff, gbase, voff) do { _Pragma("unroll") for (int _i = 0; _i < 2; ++_i) \
        __builtin_amdgcn_global_load_lds((const unsigned*)((const char*)(gbase) + (voff)[_i]), (PG8_LAS unsigned*)(lds + (bufoff) + ldsw + _i * 8192), 16, 0, 0); } while (0)
#define PG8_LDA(dst, b, h) do { _Pragma("unroll") for (int m = 0; m < 4; ++m) _Pragma("unroll") for (int k = 0; k < 2; ++k) dst[m][k] = *(const PG8_LAS bf16x8*)(lds + PG8_SA(b, h) + aoff + m * 2048 + k * 1024); } while (0)
#define PG8_LDB(dst, b, h) do { _Pragma("unroll") for (int n = 0; n < 2; ++n) _Pragma("unroll") for (int k = 0; k < 2; ++k) dst[n][k] = *(const PG8_LAS bf16x8*)(lds + PG8_SB(b, h) + boff + n * 2048 + k * 1024); } while (0)
#define PG8_MMA(ai, bj, At, Bt) do { __builtin_amdgcn_s_setprio(1); _Pragma("unroll") for (int m = 0; m < 4; ++m) _Pragma("unroll") for (int n = 0; n < 2; ++n) _Pragma("unroll") for (int k = 0; k < 2; ++k) \
        acc[ai][bj][m][n] = __builtin_amdgcn_mfma_f32_16x16x32_bf16(Bt[n][k], At[m][k], acc[ai][bj][m][n], 0, 0, 0); __builtin_amdgcn_s_setprio(0); } while (0)
#define PG8_WAIT_V(n) asm volatile("s_waitcnt vmcnt(" #n ")" ::: "memory")
#define PG8_WAIT_L(n) asm volatile("s_waitcnt lgkmcnt(" #n ")" ::: "memory")
#define PG8_BAR __builtin_amdgcn_s_barrier()
#define PG8_SCHED __builtin_amdgcn_sched_barrier(0)
    Unit cur, nxt; int ui = 0;
    if (!S.next(0, cur)) return;
    f32x4 acc[2][2][4][2];
#pragma unroll
    for (int a = 0; a < 2; ++a)
#pragma unroll
        for (int b = 0; b < 2; ++b)
#pragma unroll
            for (int m = 0; m < 4; ++m)
#pragma unroll
                for (int n = 0; n < 2; ++n) acc[a][b][m][n] = (f32x4){0.f, 0.f, 0.f, 0.f};
    bf16x8 At[4][2], B0[2][2], B1[2][2];
    const char* cA = (const char*)g.A + (size_t)cur.pm * tstep; const char* cB = (const char*)g.Bt + (size_t)cur.pn * tstep;
    S.a_ready(cur);
    if constexpr (SP2) {
        PG8_STAGE(PG8_SB(0, 0), cB, voffB); PG8_STAGE(PG8_SB(0, 1), cB + hstep, voffB); PG8_STAGE(PG8_SA(0, 0), cA, voffA); PG8_STAGE(PG8_SA(0, 1), cA + hstep, voffA);
        if (wr == 1) PG8_BAR;
        PG8_WAIT_V(2); PG8_BAR;
        PG8_STAGE(PG8_SB(1, 0), cB + kstep, voffB); PG8_STAGE(PG8_SA(1, 0), cA + kstep, voffA); PG8_STAGE(PG8_SB(1, 1), cB + hstep + kstep, voffB);
        PG8_WAIT_V(6); PG8_BAR;
    } else {
        PG8_STAGE(PG8_SB(0, 0), cB, voffB); PG8_STAGE(PG8_SA(0, 0), cA, voffA); PG8_STAGE(PG8_SB(0, 1), cB + hstep, voffB); PG8_STAGE(PG8_SA(0, 1), cA + hstep, voffA);
        if (wr == 1) PG8_BAR;
        PG8_WAIT_V(4); PG8_BAR;
        PG8_STAGE(PG8_SB(1, 0), cB + kstep, voffB); PG8_STAGE(PG8_SA(1, 0), cA + kstep, voffA); PG8_STAGE(PG8_SB(1, 1), cB + hstep + kstep, voffB);
        PG8_WAIT_V(6); PG8_BAR;
    }
    for (;;) {
        const bool has_next = S.next(ui + 1, nxt);
        const char* nA = has_next ? (const char*)g.A + (size_t)nxt.pm * tstep : cA; const char* nB = has_next ? (const char*)g.Bt + (size_t)nxt.pn * tstep : cB;
        for (int t = 0; t < nt; t += 2) {
            if constexpr (Epi::MID) { if (t == (nt >> 1)) E.mid(acc, cur, wr, fr); }
            const bool last = (t == nt - 2);
            const char* a1 = cA + (size_t)(t + 1) * kstep;
            const char* a2 = last ? nA : cA + (size_t)(t + 2) * kstep; const char* b2 = last ? nB : cB + (size_t)(t + 2) * kstep;
            const char* a3 = a2 + kstep; const char* b3 = b2 + kstep;
            if (last && has_next) S.a_ready(nxt);
            if constexpr (SP2) {
            PG8_LDB(B0, 0, 0); PG8_LDB(B1, 0, 1); PG8_SCHED; PG8_LDA(At, 0, 0); PG8_STAGE(PG8_SA(1, 1), a1 + hstep, voffA);
            PG8_WAIT_V(8); PG8_WAIT_L(0); PG8_BAR; PG8_MMA(0, 0, At, B0); PG8_MMA(0, 1, At, B1); PG8_BAR; PG8_SCHED;
            PG8_LDA(At, 0, 1); PG8_STAGE(PG8_SB(0, 0), b2, voffB); PG8_STAGE(PG8_SB(0, 1), b2 + hstep, voffB); PG8_STAGE(PG8_SA(0, 0), a2, voffA);
            PG8_WAIT_V(8); PG8_WAIT_L(0); PG8_BAR; PG8_MMA(1, 0, At, B0); PG8_MMA(1, 1, At, B1); PG8_BAR; PG8_SCHED;
            PG8_LDB(B0, 1, 0); PG8_LDB(B1, 1, 1); PG8_SCHED; PG8_LDA(At, 1, 0); PG8_STAGE(PG8_SA(0, 1), a2 + hstep, voffA);
            PG8_WAIT_V(8); PG8_WAIT_L(0); PG8_BAR; PG8_MMA(0, 0, At, B0); PG8_MMA(0, 1, At, B1); PG8_BAR; PG8_SCHED;
            PG8_LDA(At, 1, 1); PG8_STAGE(PG8_SB(1, 0), b3, voffB); PG8_STAGE(PG8_SB(1, 1), b3 + hstep, voffB); PG8_STAGE(PG8_SA(1, 0), a3, voffA);
            PG8_WAIT_V(8); PG8_WAIT_L(0); PG8_BAR; PG8_MMA(1, 0, At, B0); PG8_MMA(1, 1, At, B1); PG8_BAR; PG8_SCHED;
            } else {
            PG8_LDB(B0, 0, 0); PG8_SCHED; PG8_LDA(At, 0, 0); PG8_STAGE(PG8_SA(1, 1), a1 + hstep, voffA);
            PG8_WAIT_L(8); PG8_BAR; PG8_WAIT_L(0); PG8_MMA(0, 0, At, B0); PG8_BAR; PG8_SCHED;
            PG8_LDB(B1, 0, 1); PG8_STAGE(PG8_SB(0, 0), b2, voffB);
            PG8_BAR; PG8_WAIT_L(0); PG8_MMA(0, 1, At, B1); PG8_BAR;
            PG8_LDA(At, 0, 1); PG8_STAGE(PG8_SA(0, 0), a2, voffA);
            PG8_BAR; PG8_WAIT_L(0); PG8_MMA(1, 0, At, B0); PG8_BAR; PG8_SCHED;
            PG8_STAGE(PG8_SB(0, 1), b2 + hstep, voffB);
            PG8_WAIT_V(6); PG8_BAR; PG8_MMA(1, 1, At, B1); PG8_BAR;
            PG8_LDB(B0, 1, 0); PG8_SCHED; PG8_LDA(At, 1, 0); PG8_STAGE(PG8_SA(0, 1), a2 + hstep, voffA);
            PG8_WAIT_L(8); PG8_BAR; PG8_WAIT_L(0); PG8_MMA(0, 0, At, B0); PG8_BAR; PG8_SCHED;
            PG8_LDB(B1, 1, 1); PG8_STAGE(PG8_SB(1, 0), b3, voffB);
            PG8_BAR; PG8_WAIT_L(0); PG8_MMA(0, 1, At, B1); PG8_BAR;
            PG8_LDA(At, 1, 1); PG8_STAGE(PG8_SA(1, 0), a3, voffA);
            PG8_BAR; PG8_WAIT_L(0); PG8_MMA(1, 0, At, B0); PG8_BAR; PG8_SCHED;
            PG8_STAGE(PG8_SB(1, 1), b3 + hstep, voffB);
            PG8_WAIT_V(6); PG8_BAR; PG8_MMA(1, 1, At, B1); PG8_BAR;
            }
        }
        if constexpr (ALIGN_EPI) { if (wr == 0) PG8_BAR; }
        if constexpr (!Epi::AFTER_DRAIN) { E(acc, cur, wr, wc, fr, fq); S.done(cur); }
        if (!has_next) break;
#pragma unroll
        for (int a = 0; a < 2; ++a)
#pragma unroll
            for (int b = 0; b < 2; ++b)
#pragma unroll
                for (int m = 0; m < 4; ++m)
#pragma unroll
                    for (int n = 0; n < 2; ++n) acc[a][b][m][n] = (f32x4){0.f, 0.f, 0.f, 0.f};
        cur = nxt; cA = nA; cB = nB; ++ui;
        if constexpr (ALIGN_EPI) { if (wr == 1) PG8_BAR; }
    }
    PG8_WAIT_V(0);
    if constexpr (!ALIGN_EPI) { if (wr == 0) PG8_BAR; }
    PG8_BAR;
    if constexpr (Epi::AFTER_DRAIN) { E.fused(acc, cur, wr, wc, fr, fq, lds, wid, lane); S.done(cur); }
#undef PG8_SA
#undef PG8_SB
#undef PG8_STAGE
#undef PG8_LDA
#undef PG8_LDB
#undef PG8_MMA
#undef PG8_WAIT_V
#undef PG8_WAIT_L
#undef PG8_BAR
#undef PG8_SCHED
}
}

constexpr int NWAVES = 8;
constexpr int S_ = 8192, DM = 2048, DFF = 5632, NMEM = 256, DIN = 5120, AW = 1024;
constexpr size_t MiB = 1u << 20;
constexpr size_t WS_CTL = 0, WS_COS = 1 * MiB, WS_SIN = 2 * MiB, WS_MK = 3 * MiB, WS_KVM = 4 * MiB;
constexpr size_t WS_WGU1 = 6 * MiB, WS_WD1 = 50 * MiB, WS_WGU2 = 72 * MiB, WS_WD2 = 116 * MiB, WS_WIN = 138 * MiB, WS_WOUT = 158 * MiB, WS_WQ = 166 * MiB, WS_WKV = 174 * MiB, WS_WO = 190 * MiB;
constexpr size_t WS_XN = 198 * MiB, WS_MIXED = 230 * MiB, WS_OB = 262 * MiB, WS_LSE = 310 * MiB, WS_ACT = 312 * MiB, WS_END = 400 * MiB;
constexpr size_t WS_Q = WS_ACT, WS_K = WS_ACT + 16 * MiB, WS_V = WS_ACT + 32 * MiB, WS_U = WS_ACT + 48 * MiB, WS_GV = WS_ACT + 64 * MiB;
constexpr size_t WS_QM = WS_ACT, WS_OM = WS_ACT + 32 * MiB;
enum { SS_X = 0, SS_H1, LN_S1, LN_S2, SS_A, SS_S, SS_H2, SS_H3, SS_H4, SS_N };
#ifndef USE_MFMA_ATTN
#define USE_MFMA_ATTN 1
#endif
#ifndef USE_MFMA_SGU
#define USE_MFMA_SGU 1
#endif
#ifndef USE_MFMA_XATTN
#define USE_MFMA_XATTN 1
#endif
constexpr int RING_BYTES = 131072, LDS_BYTES = 147456;

#define LAS __attribute__((address_space(3)))
typedef unsigned short bf16;
typedef unsigned v4u __attribute__((ext_vector_type(4)));
typedef unsigned v2u __attribute__((ext_vector_type(2)));
typedef float f32x4 __attribute__((ext_vector_type(4)));
typedef short bf16x8 __attribute__((ext_vector_type(8)));
#define LDS_WAIT() asm volatile("s_waitcnt lgkmcnt(0)" ::: "memory")
__device__ __forceinline__ unsigned f2bf(float f) { unsigned u = __builtin_bit_cast(unsigned, f); return (u + 0x7fffu + ((u >> 16) & 1u)) >> 16; }
__device__ __forceinline__ unsigned pk2(float lo, float hi) { return f2bf(lo) | (f2bf(hi) << 16); }
__device__ __forceinline__ float bf2f(unsigned short b) { return __uint_as_float((unsigned)b << 16); }
__device__ __forceinline__ float wave_sum(float v) {
#pragma unroll
    for (int o = 1; o < 64; o <<= 1) v += __shfl_xor(v, o);
    return v;
}
__device__ __forceinline__ float wave_max(float v) {
#pragma unroll
    for (int o = 1; o < 64; o <<= 1) v = fmaxf(v, __shfl_xor(v, o));
    return v;
}

__constant__ double INVF[32] = {1.0, 0.7498942093324559, 0.5623413251903491, 0.4216965034285822, 0.31622776601683794, 0.23713737056616552, 0.1778279410038923, 0.1333521432163324, 0.1, 0.07498942093324558, 0.05623413251903491, 0.042169650342858224, 0.03162277660168379, 0.023713737056616554, 0.01778279410038923, 0.01333521432163324, 0.01, 0.007498942093324558, 0.005623413251903491, 0.004216965034285823, 0.0031622776601683794, 0.0023713737056616554, 0.0017782794100389228, 0.001333521432163324, 0.001, 0.0007498942093324559, 0.0005623413251903491, 0.00042169650342858224, 0.00031622776601683794, 0.00023713737056616554, 0.00017782794100389227, 0.0001333521432163324};

struct Args { const void* in[27]; float* out; unsigned char* ws; int ph_lo, ph_hi; };

__device__ __forceinline__ void transpose_item(const float* W, int K, int N, const float* gain, bf16* WT, int k0, int n0, int dst_row0, LAS float* scr, int lane) {
#pragma unroll 8
    for (int i = 0; i < 32; ++i) { const int kk = 2 * i + (lane >> 5); float v = W[(size_t)(k0 + kk) * N + n0 + (lane & 31)]; if (gain) v *= gain[k0 + kk]; scr[kk * 33 + (lane & 31)] = v; }
    LDS_WAIT(); asm volatile("" ::: "memory");
    const int c = lane & 7;
#pragma unroll
    for (int j = 0; j < 4; ++j) { const int n = (lane >> 3) + 8 * j; const LAS float* s = scr + (8 * c) * 33 + n;
        v4u o; o.x = pk2(s[0 * 33], s[1 * 33]); o.y = pk2(s[2 * 33], s[3 * 33]); o.z = pk2(s[4 * 33], s[5 * 33]); o.w = pk2(s[6 * 33], s[7 * 33]);
        *(v4u*)(WT + (size_t)(dst_row0 + n) * K + k0 + 8 * c) = o; }
    LDS_WAIT(); asm volatile("" ::: "memory");
}
__device__ __forceinline__ void tr_job(const float* W, int K, int N, const float* g1, const float* g2, bf16* WT, int row_off, int mode, int item, LAS float* scr, int lane) {
    const int nblk = N / 32, kb = item / nblk, nb = item % nblk, k0 = 64 * kb, n0 = 32 * nb;
    const float* gain = g1; if (g2 && k0 >= 1024) gain = g2 - 1024;
    int dr = row_off + n0;
    if (mode == 1 || mode == 2) dr = (n0 >> 7) * 256 + (mode == 2 ? 128 : 0) + (n0 & 127);
    else if (mode == 3 && n0 < 2048) dr = (n0 >> 8) * 256 + ((n0 >> 5) & 1) * 128 + ((n0 >> 6) & 3) * 32;
    transpose_item(W, K, N, gain, WT, k0, n0, dr, scr, lane);
}

__device__ __forceinline__ void attn_naive(LAS unsigned char* lds, const bf16* Q, const bf16* K, const bf16* V, bf16* MIXED, float* ss_a, int gw, int NGW, int wave, int lane) {
    LAS float* qs = (LAS float*)lds + wave * 64;
    for (int wu = gw; wu < S_ * 16; wu += NGW) {
        const int t = wu >> 4, h = wu & 15;
        qs[lane] = bf2f(Q[(size_t)t * AW + h * 64 + lane]);
        LDS_WAIT(); asm volatile("" ::: "memory");
        float sc[9];
#pragma unroll
        for (int b = 0; b < 3; ++b)
#pragma unroll
            for (int p = 0; p < 3; ++p) {
                const int diff = 64 * p + lane, kt = t - (diff << (2 * b)); const bool valid = (diff <= 128) && (kt >= 0);
                float dot = 0.f;
                if (valid) { const bf16x8* kr = (const bf16x8*)(K + (size_t)kt * AW + h * 64);
#pragma unroll
                    for (int c = 0; c < 8; ++c) { const bf16x8 kv = kr[c];
#pragma unroll
                        for (int e = 0; e < 8; ++e) dot += qs[8 * c + e] * bf2f((unsigned short)kv[e]); } }
                sc[b * 3 + p] = valid ? dot * 0.125f : -INFINITY;
            }
        float m = sc[0];
#pragma unroll
        for (int i = 1; i < 9; ++i) m = fmaxf(m, sc[i]);
        m = wave_max(m);
        float l = 0.f;
#pragma unroll
        for (int i = 0; i < 9; ++i) { sc[i] = __expf(sc[i] - m); l += sc[i]; }
        l = wave_sum(l);
        float o = 0.f;
#pragma unroll
        for (int b = 0; b < 3; ++b)
#pragma unroll
            for (int p = 0; p < 3; ++p) {
                const int pbits = __float_as_int(sc[b * 3 + p]);
                for (int j = 0; j < 64; ++j) { const int diff = 64 * p + j, kt = t - (diff << (2 * b));
                    if (diff <= 128 && kt >= 0) { const float pj = __int_as_float(__builtin_amdgcn_readlane(pbits, j)); o += pj * bf2f(V[(size_t)kt * AW + h * 64 + lane]); } }
            }
        o = o / l;
        MIXED[(size_t)t * DM + h * 64 + lane] = (bf16)f2bf(o);
        const float q = wave_sum(o * o); if (lane == 0) atomicAdd(ss_a + t, q);
        asm volatile("" ::: "memory");
    }
}

__device__ __forceinline__ void sgu_naive(LAS unsigned char* lds, const bf16* U, const bf16* GV, const float* ln_s1, const float* ln_s2, const float* ln_g, const float* ln_b, const float* w_s, const float* b_s,
                                          bf16* MIXED, float* ss_s, int bx, int G, int tid, int lane) {
    LAS float* GT = (LAS float*)lds;
    LAS float* WL = (LAS float*)(lds + 65536);
    for (int unit = bx; unit < 64 * 8; unit += G) {
        const int c = unit >> 3, g = unit & 7;
        for (int idx = tid; idx < 128 * 128; idx += NWAVES * 64) {
            const int j = idx >> 7, d = idx & 127, tok = c * 128 + j, ch = g * 128 + d;
            const float mean = ln_s1[tok] * (1.0f / AW), var = ln_s2[tok] * (1.0f / AW) - mean * mean, rstd = 1.0f / sqrtf(var + 1e-6f);
            GT[idx] = (bf2f(GV[(size_t)tok * AW + ch]) - mean) * rstd * ln_g[ch] + ln_b[ch];
            WL[idx] = (d <= j) ? w_s[(size_t)g * 16384 + idx] : 0.f;
        }
        __syncthreads();
        const int d = tid & 127, iq = tid >> 7;
        for (int ii = 0; ii < 32; ++ii) {
            const int i = iq * 32 + ii; float acc = 0.f;
            for (int j = 0; j <= i; ++j) acc += WL[i * 128 + j] * GT[j * 128 + d];
            const int tok = c * 128 + i; const float sv = acc + b_s[g * 128 + i];
            const float o = bf2f(U[(size_t)tok * AW + g * 128 + d]) * sv;
            MIXED[(size_t)tok * DM + AW + g * 128 + d] = (bf16)f2bf(o);
            const float q = wave_sum(o * o); if (lane == 0) atomicAdd(ss_s + tok, q);
        }
        __syncthreads();
    }
}

__device__ __forceinline__ void xattn_naive(LAS unsigned char* lds, const bf16* QM, const bf16* KVM, bf16* OM, int gw, int NGW, int wave, int lane) {
    LAS float* qs = (LAS float*)lds + wave * 512;
    for (int wu = gw; wu < S_ * 4; wu += NGW) {
        const int t = wu >> 2, h = wu & 3;
        { const bf16x8 qv = *(const bf16x8*)(QM + (size_t)t * DM + h * 512 + lane * 8);
#pragma unroll
          for (int e = 0; e < 8; ++e) qs[lane * 8 + e] = bf2f((unsigned short)qv[e]); }
        LDS_WAIT(); asm volatile("" ::: "memory");
        float sc[4];
#pragma unroll
        for (int p = 0; p < 4; ++p) {
            const bf16x8* kr = (const bf16x8*)(KVM + (size_t)(64 * p + lane) * (2 * DM) + h * 512); float dot = 0.f;
            for (int c = 0; c < 64; ++c) { const bf16x8 kv = kr[c];
#pragma unroll
                for (int e = 0; e < 8; ++e) dot += qs[8 * c + e] * bf2f((unsigned short)kv[e]); }
            sc[p] = dot * 0.044194173824159216f;
        }
        float m = wave_max(fmaxf(fmaxf(sc[0], sc[1]), fmaxf(sc[2], sc[3])));
        float l = 0.f;
#pragma unroll
        for (int p = 0; p < 4; ++p) { sc[p] = __expf(sc[p] - m); l += sc[p]; }
        l = wave_sum(l);
        float o[8];
#pragma unroll
        for (int e = 0; e < 8; ++e) o[e] = 0.f;
#pragma unroll
        for (int p = 0; p < 4; ++p) { const int pbits = __float_as_int(sc[p]);
            for (int j = 0; j < 64; ++j) { const float pj = __int_as_float(__builtin_amdgcn_readlane(pbits, j));
                const bf16x8 vv = *(const bf16x8*)(KVM + (size_t)(64 * p + j) * (2 * DM) + DM + h * 512 + lane * 8);
#pragma unroll
                for (int e = 0; e < 8; ++e) o[e] += pj * bf2f((unsigned short)vv[e]); } }
        const float il = 1.0f / l;
        v4u w; w.x = pk2(o[0] * il, o[1] * il); w.y = pk2(o[2] * il, o[3] * il); w.z = pk2(o[4] * il, o[5] * il); w.w = pk2(o[6] * il, o[7] * il);
        *(v4u*)(OM + (size_t)t * DM + h * 512 + lane * 8) = w;
        asm volatile("" ::: "memory");
    }
}

typedef short v4s __attribute__((ext_vector_type(4)));
__device__ __forceinline__ v4s tr_read8(LAS unsigned char* p) { return __builtin_amdgcn_ds_read_tr16_b64_v4i16((LAS v4s*)p); }
__device__ __forceinline__ bf16x8 join8(v4s lo, v4s hi) { return (bf16x8){lo[0], lo[1], lo[2], lo[3], hi[0], hi[1], hi[2], hi[3]}; }
__device__ __forceinline__ unsigned cvtpk(float lo, float hi) { unsigned r; asm volatile("v_cvt_pk_bf16_f32 %0, %1, %2" : "=v"(r) : "v"(lo), "v"(hi)); return r; }
__device__ __forceinline__ bf16x8 packP(const f32x4 a, const f32x4 b) { v4u w; w.x = cvtpk(a[0], a[1]); w.y = cvtpk(a[2], a[3]); w.z = cvtpk(b[0], b[1]); w.w = cvtpk(b[2], b[3]); return __builtin_bit_cast(bf16x8, w); }
#define MFMA16(a, b, c) __builtin_amdgcn_mfma_f32_16x16x32_bf16((a), (b), (c), 0, 0, 0)
constexpr int KV_PB = 144, KV_TILE = 256 * KV_PB;

__device__ __forceinline__ void dattn_mfma(LAS unsigned char* lds, const bf16* Q, const bf16* K, const bf16* V, bf16* OB, float* LSE, int bx, int G, int tid, int wave, int lane) {
    asm volatile("" : "+v"(tid), "+v"(lane), "+s"(wave), "+s"(bx));
    const int g = lane >> 4, i16 = lane & 15, q4 = i16 >> 2, p4 = lane & 3;
    LAS unsigned char* Ks = lds; LAS unsigned char* Vs = lds + KV_TILE;
    constexpr int NU = 3 * 16 * 64;
    v4u kreg[4], vreg[4];
#define DA_DECODE(u, b, h, r, n, dsh) const int b = (u) >> 10, h = (u) & 15, dsh = 2 * b, r = (((u) & 1023) >> 4) & ((1 << dsh) - 1), n = (((u) & 1023) >> 4) >> dsh
#define DA_GLOAD(u) do { DA_DECODE(u, b_, h_, r_, n_, dsh_); (void)b_; _Pragma("unroll") for (int i = 0; i < 4; ++i) { const int id = tid + 512 * i, row = id >> 3, ch = id & 7, s = 128 * (n_ - 1) + row; \
        if (s >= 0) { const size_t off = ((size_t)r_ + ((size_t)s << dsh_)) * AW + h_ * 64 + ch * 8; kreg[i] = *(const v4u*)(K + off); vreg[i] = *(const v4u*)(V + off); } \
        else { kreg[i] = (v4u){0u, 0u, 0u, 0u}; vreg[i] = (v4u){0u, 0u, 0u, 0u}; } } } while (0)
    int u = bx;
    if (u < NU) DA_GLOAD(u);
    for (; u < NU; u += G) {
#pragma unroll
        for (int i = 0; i < 4; ++i) { const int id = tid + 512 * i, row = id >> 3, ch = id & 7; *(LAS v4u*)(Ks + row * KV_PB + ch * 16) = kreg[i]; *(LAS v4u*)(Vs + row * KV_PB + ch * 16) = vreg[i]; }
        __syncthreads();
        if (u + G < NU) DA_GLOAD(u + G);
        DA_DECODE(u, b, h, r, n, dsh);
        const int qi = 16 * wave + i16;
        const size_t qtok = (size_t)r + ((size_t)(128 * n + qi) << dsh);
        const bf16x8 qf0 = *(const bf16x8*)(Q + qtok * AW + h * 64 + 8 * g), qf1 = *(const bf16x8*)(Q + qtok * AW + h * 64 + 32 + 8 * g);
        f32x4 s[9];
#pragma unroll
        for (int t = 0; t < 9; ++t) { LAS unsigned char* kp = Ks + (16 * (wave + t) + i16) * KV_PB + g * 16;
            const bf16x8 k0 = *(LAS bf16x8*)kp, k1 = *(LAS bf16x8*)(kp + 64);
            s[t] = MFMA16(k0, qf0, ((f32x4){0.f, 0.f, 0.f, 0.f})); s[t] = MFMA16(k1, qf1, s[t]); }
        float mx = -INFINITY;
#pragma unroll
        for (int t = 0; t < 9; ++t)
#pragma unroll
            for (int e = 0; e < 4; ++e) { const int kj = 16 * (wave + t) + 4 * g + e, diff = qi + 128 - kj; const bool valid = (diff >= 0) && (diff <= 128) && (n > 0 || kj >= 128);
                const float v = valid ? s[t][e] * (0.125f * 1.4426950408889634f) : -INFINITY; s[t][e] = v; mx = fmaxf(mx, v); }
        mx = fmaxf(mx, __shfl_xor(mx, 16)); mx = fmaxf(mx, __shfl_xor(mx, 32));
        float l = 0.f;
#pragma unroll
        for (int t = 0; t < 9; ++t)
#pragma unroll
            for (int e = 0; e < 4; ++e) { const float p = __builtin_amdgcn_exp2f(s[t][e] - mx); s[t][e] = p; l += p; }
        l += __shfl_xor(l, 16); l += __shfl_xor(l, 32);
        f32x4 o[4];
#pragma unroll
        for (int dt = 0; dt < 4; ++dt) o[dt] = (f32x4){0.f, 0.f, 0.f, 0.f};
#pragma unroll
        for (int c = 0; c < 5; ++c) {
            const bf16x8 pf = packP(s[2 * c], (2 * c + 1 < 9) ? s[(2 * c + 1 < 9) ? 2 * c + 1 : 8] : (f32x4){0.f, 0.f, 0.f, 0.f});
            const int ktB = (wave + 2 * c + 1 < 16) ? wave + 2 * c + 1 : 15;
            LAS unsigned char* va = Vs + (16 * (wave + 2 * c) + 4 * g + q4) * KV_PB + p4 * 8; LAS unsigned char* vb = Vs + (16 * ktB + 4 * g + q4) * KV_PB + p4 * 8;
#pragma unroll
            for (int dt = 0; dt < 4; ++dt) { const v4s lo = tr_read8(va + dt * 32), hi = tr_read8(vb + dt * 32); o[dt] = MFMA16(join8(lo, hi), pf, o[dt]); }
        }
        const float il = 1.0f / l;
        bf16* op = OB + ((size_t)b * S_ + qtok) * AW + h * 64 + 4 * g;
#pragma unroll
        for (int dt = 0; dt < 4; ++dt) { v2u w; w.x = cvtpk(o[dt][0] * il, o[dt][1] * il); w.y = cvtpk(o[dt][2] * il, o[dt][3] * il); *(v2u*)(op + 16 * dt) = w; }
        if (g == 0) LSE[((size_t)b * S_ + qtok) * 16 + h] = mx + __builtin_amdgcn_logf(l);
        __syncthreads();
    }
#undef DA_DECODE
#undef DA_GLOAD
}

__device__ __forceinline__ void sgu_mfma(LAS unsigned char* lds, const bf16* U, const bf16* GV, const float* ln_s1, const float* ln_s2, const float* ln_g, const float* ln_b, const float* w_s, const float* b_s,
                                         bf16* MIXED, float* ss_s, int bx, int G, int tid, int wave, int lane) {
    asm volatile("" : "+v"(tid), "+v"(lane), "+s"(wave), "+s"(bx));
    const int g = lane >> 4, i16 = lane & 15, q4 = i16 >> 2, p4 = lane & 3;
    constexpr int PB = 272;
    LAS unsigned char* GN = lds; LAS unsigned char* WS = lds + 128 * PB;
    for (int unit = bx; unit < 64 * 8; unit += G) {
        const int c = unit >> 3, grp = unit & 7;
#pragma unroll
        for (int k = 0; k < 4; ++k) { const int id = tid + 512 * k, j = id >> 4, ch = id & 15, tok = c * 128 + j;
            const bf16x8 gv = *(const bf16x8*)(GV + (size_t)tok * AW + grp * 128 + 8 * ch);
            const float mean = ln_s1[tok] * (1.0f / AW), var = ln_s2[tok] * (1.0f / AW) - mean * mean, rstd = 1.0f / sqrtf(var + 1e-6f);
            const f32x4 lg0 = *(const f32x4*)(ln_g + grp * 128 + 8 * ch), lg1 = *(const f32x4*)(ln_g + grp * 128 + 8 * ch + 4), lb0 = *(const f32x4*)(ln_b + grp * 128 + 8 * ch), lb1 = *(const f32x4*)(ln_b + grp * 128 + 8 * ch + 4);
            f32x4 x0, x1;
#pragma unroll
            for (int e = 0; e < 4; ++e) { x0[e] = (bf2f((unsigned short)gv[e]) - mean) * rstd * lg0[e] + lb0[e]; x1[e] = (bf2f((unsigned short)gv[4 + e]) - mean) * rstd * lg1[e] + lb1[e]; }
            *(LAS bf16x8*)(GN + j * PB + ch * 16) = packP(x0, x1);
            f32x4 w0 = *(const f32x4*)(w_s + (size_t)grp * 16384 + j * 128 + 8 * ch), w1 = *(const f32x4*)(w_s + (size_t)grp * 16384 + j * 128 + 8 * ch + 4);
#pragma unroll
            for (int e = 0; e < 4; ++e) { if (8 * ch + e > j) w0[e] = 0.f; if (8 * ch + 4 + e > j) w1[e] = 0.f; }
            *(LAS bf16x8*)(WS + j * PB + ch * 16) = packP(w0, w1); }
        __syncthreads();
        f32x4 acc[8];
#pragma unroll
        for (int it = 0; it < 8; ++it) acc[it] = (f32x4){0.f, 0.f, 0.f, 0.f};
#pragma unroll
        for (int ks = 0; ks < 4; ++ks) {
            const v4s lo = tr_read8(GN + (32 * ks + 8 * g + q4) * PB + (16 * wave + 4 * p4) * 2), hi = tr_read8(GN + (32 * ks + 8 * g + 4 + q4) * PB + (16 * wave + 4 * p4) * 2);
            const bf16x8 gf = join8(lo, hi);
#pragma unroll
            for (int it = 0; it < 8; ++it) if (it >= 2 * ks) { const bf16x8 wf = *(LAS bf16x8*)(WS + (16 * it + i16) * PB + (32 * ks + 8 * g) * 2); acc[it] = MFMA16(gf, wf, acc[it]); }
        }
#pragma unroll
        for (int it = 0; it < 8; ++it) { const int i = 16 * it + i16, tok = c * 128 + i, chn = grp * 128 + 16 * wave + 4 * g; const float bias = b_s[grp * 128 + i];
            const v2u uu = *(const v2u*)(U + (size_t)tok * AW + chn);
            const float o0 = bf2f((unsigned short)(uu.x & 0xffff)) * (acc[it][0] + bias), o1 = bf2f((unsigned short)(uu.x >> 16)) * (acc[it][1] + bias);
            const float o2 = bf2f((unsigned short)(uu.y & 0xffff)) * (acc[it][2] + bias), o3 = bf2f((unsigned short)(uu.y >> 16)) * (acc[it][3] + bias);
            v2u w; w.x = cvtpk(o0, o1); w.y = cvtpk(o2, o3); *(v2u*)(MIXED + (size_t)tok * DM + AW + chn) = w;
            float q = (o0 * o0 + o1 * o1) + (o2 * o2 + o3 * o3); q += __shfl_xor(q, 16); q += __shfl_xor(q, 32);
            if (g == 0) atomicAdd(ss_s + tok, q); }
        __syncthreads();
    }
}

__device__ __forceinline__ void xattn_mfma(LAS unsigned char* lds, const bf16* QM, const bf16* KVM, bf16* OM, int bx, int G, int tid, int wave, int lane) {
    asm volatile("" : "+v"(tid), "+v"(lane), "+s"(wave), "+s"(bx));
    const int g = lane >> 4, i16 = lane & 15, q4 = i16 >> 2, p4 = lane & 3;
    v4u reg[4];
#define XA_GLOAD(c) do { _Pragma("unroll") for (int i = 0; i < 4; ++i) { const int id = tid + 512 * i, row = id >> 3, ch = id & 7; \
        reg[i] = *(const v4u*)(KVM + (size_t)row * (2 * DM) + (((c) >> 3) ? DM : 0) + h * 512 + 64 * ((c) & 7) + ch * 8); } } while (0)
#define XA_WRITE(buf) do { _Pragma("unroll") for (int i = 0; i < 4; ++i) { const int id = tid + 512 * i, row = id >> 3, ch = id & 7; *(LAS v4u*)((buf) + row * KV_PB + ch * 16) = reg[i]; } } while (0)
    for (int unit = bx; unit < 256; unit += G) {
        const int h = unit & 3, qt = unit >> 2;
        const size_t tokq = (size_t)128 * qt + 16 * wave + i16;
        XA_GLOAD(0); XA_WRITE(lds); __syncthreads();
        f32x4 s[16];
#pragma unroll
        for (int kt = 0; kt < 16; ++kt) s[kt] = (f32x4){0.f, 0.f, 0.f, 0.f};
        for (int c = 0; c < 8; ++c) {
            XA_GLOAD(c + 1);
            LAS unsigned char* buf = lds + (c & 1) * KV_TILE;
            const bf16x8 qf0 = *(const bf16x8*)(QM + tokq * DM + h * 512 + 64 * c + 8 * g), qf1 = *(const bf16x8*)(QM + tokq * DM + h * 512 + 64 * c + 32 + 8 * g);
#pragma unroll
            for (int kt = 0; kt < 16; ++kt) { LAS unsigned char* kp = buf + (16 * kt + i16) * KV_PB + g * 16;
                const bf16x8 k0 = *(LAS bf16x8*)kp, k1 = *(LAS bf16x8*)(kp + 64); s[kt] = MFMA16(k0, qf0, s[kt]); s[kt] = MFMA16(k1, qf1, s[kt]); }
            XA_WRITE(lds + ((c + 1) & 1) * KV_TILE);
            __syncthreads();
        }
        float mx = -INFINITY;
#pragma unroll
        for (int kt = 0; kt < 16; ++kt)
#pragma unroll
            for (int e = 0; e < 4; ++e) { s[kt][e] *= (0.044194173824159216f * 1.4426950408889634f); mx = fmaxf(mx, s[kt][e]); }
        mx = fmaxf(mx, __shfl_xor(mx, 16)); mx = fmaxf(mx, __shfl_xor(mx, 32));
        float l = 0.f;
#pragma unroll
        for (int kt = 0; kt < 16; ++kt)
#pragma unroll
            for (int e = 0; e < 4; ++e) { const float p = __builtin_amdgcn_exp2f(s[kt][e] - mx); s[kt][e] = p; l += p; }
        l += __shfl_xor(l, 16); l += __shfl_xor(l, 32);
        const float il = 1.0f / l;
        bf16x8 pf[8];
#pragma unroll
        for (int kc = 0; kc < 8; ++kc) pf[kc] = packP(s[2 * kc], s[2 * kc + 1]);
        for (int c = 8; c < 16; ++c) {
            if (c + 1 < 16) XA_GLOAD(c + 1);
            LAS unsigned char* buf = lds + (c & 1) * KV_TILE;
            f32x4 o[4];
#pragma unroll
            for (int dt = 0; dt < 4; ++dt) o[dt] = (f32x4){0.f, 0.f, 0.f, 0.f};
#pragma unroll
            for (int kc = 0; kc < 8; ++kc) { LAS unsigned char* va = buf + (32 * kc + 4 * g + q4) * KV_PB + p4 * 8; LAS unsigned char* vb = va + 16 * KV_PB;
#pragma unroll
                for (int dt = 0; dt < 4; ++dt) { const v4s lo = tr_read8(va + dt * 32), hi = tr_read8(vb + dt * 32); o[dt] = MFMA16(join8(lo, hi), pf[kc], o[dt]); } }
            bf16* op = OM + tokq * DM + h * 512 + 64 * (c - 8) + 4 * g;
#pragma unroll
            for (int dt = 0; dt < 4; ++dt) { v2u w; w.x = cvtpk(o[dt][0] * il, o[dt][1] * il); w.y = cvtpk(o[dt][2] * il, o[dt][3] * il); *(v2u*)(op + 16 * dt) = w; }
            if (c + 1 < 16) XA_WRITE(lds + ((c + 1) & 1) * KV_TILE);
            __syncthreads();
        }
    }
#undef XA_GLOAD
#undef XA_WRITE
}

__global__ void __launch_bounds__(NWAVES * 64, 2) mega_fwd(Args args) {
    extern __shared__ __attribute__((aligned(16))) unsigned char lds_raw[];
    LAS unsigned char* lds = (LAS unsigned char*)lds_raw;
    cg::grid_group grid = cg::this_grid();
    const int tid = threadIdx.x, lane = tid & 63, wave = __builtin_amdgcn_readfirstlane(tid >> 6);
    const int G = gridDim.x, bx = blockIdx.x;
    unsigned char* ws = args.ws;
    float* SS = (float*)(ws + WS_CTL);
    float* cosT = (float*)(ws + WS_COS); float* sinT = (float*)(ws + WS_SIN);
    bf16* MK = (bf16*)(ws + WS_MK); bf16* KVM = (bf16*)(ws + WS_KVM);
    bf16* WGU1 = (bf16*)(ws + WS_WGU1); bf16* WD1 = (bf16*)(ws + WS_WD1); bf16* WGU2 = (bf16*)(ws + WS_WGU2); bf16* WD2 = (bf16*)(ws + WS_WD2);
    bf16* WIN = (bf16*)(ws + WS_WIN); bf16* WOUT = (bf16*)(ws + WS_WOUT); bf16* WQ = (bf16*)(ws + WS_WQ); bf16* WKV = (bf16*)(ws + WS_WKV); bf16* WO = (bf16*)(ws + WS_WO);
    bf16* XN = (bf16*)(ws + WS_XN); bf16* MIXED = (bf16*)(ws + WS_MIXED); bf16* HB = (bf16*)(ws + WS_ACT);
    bf16* Qb = (bf16*)(ws + WS_Q); bf16* Kb = (bf16*)(ws + WS_K); bf16* Vb = (bf16*)(ws + WS_V); bf16* Ub = (bf16*)(ws + WS_U); bf16* GVb = (bf16*)(ws + WS_GV);
    bf16* OBb = (bf16*)(ws + WS_OB); float* LSEb = (float*)(ws + WS_LSE);
    bf16* QM = (bf16*)(ws + WS_QM); bf16* OM = (bf16*)(ws + WS_OM);
    const float* x = (const float*)args.in[0]; const float* mem = (const float*)args.in[1]; const int* positions = (const int*)args.in[2];
    float* HRES = args.out;
    const int lo = args.ph_lo, hi = args.ph_hi;
#ifndef PMASK
#define PMASK 0xFFFF
#endif
#define IN(k) (lo <= (k) && (k) < hi && ((PMASK >> (k)) & 1))
#define SEAM(k) do { if (IN(k) && IN((k) + 1)) grid.sync(); } while (0)
    const int gw = bx * NWAVES + wave, NGW = G * NWAVES;
    const int gt = bx * (NWAVES * 64) + tid, NGT = G * NWAVES * 64;

    if (IN(0)) {
        LAS float* scr = (LAS float*)(lds + wave * 16384);
#define INF(k) ((const float*)args.in[k])
        constexpr int I_GU = (DM / 64) * (DFF / 32), I_D = (DFF / 64) * (DM / 32), I_IN = (DM / 64) * (DIN / 32), I_SQ = (DM / 64) * (DM / 32);
        constexpr int NITEMS = 2 * (2 * I_GU + I_D) + I_IN + 5 * I_SQ;
        for (int it = gw; it < NITEMS; it += NGW) {
            int r = it;
            if (r < I_GU) { tr_job(INF(4), DM, DFF, INF(3), nullptr, WGU1, 0, 1, r, scr, lane); continue; } r -= I_GU;
            if (r < I_GU) { tr_job(INF(5), DM, DFF, INF(3), nullptr, WGU1, 0, 2, r, scr, lane); continue; } r -= I_GU;
            if (r < I_D) { tr_job(INF(6), DFF, DM, nullptr, nullptr, WD1, 0, 0, r, scr, lane); continue; } r -= I_D;
            if (r < I_GU) { tr_job(INF(23), DM, DFF, INF(22), nullptr, WGU2, 0, 1, r, scr, lane); continue; } r -= I_GU;
            if (r < I_GU) { tr_job(INF(24), DM, DFF, INF(22), nullptr, WGU2, 0, 2, r, scr, lane); continue; } r -= I_GU;
            if (r < I_D) { tr_job(INF(25), DFF, DM, nullptr, nullptr, WD2, 0, 0, r, scr, lane); continue; } r -= I_D;
            if (r < I_IN) { tr_job(INF(8), DM, DIN, INF(7), nullptr, WIN, 0, 3, r, scr, lane); continue; } r -= I_IN;
            if (r < I_SQ) { tr_job(INF(15), DM, DM, INF(13), INF(14), WOUT, 0, 0, r, scr, lane); continue; } r -= I_SQ;
            if (r < I_SQ) { tr_job(INF(18), DM, DM, INF(16), nullptr, WQ, 0, 0, r, scr, lane); continue; } r -= I_SQ;
            if (r < I_SQ) { tr_job(INF(19), DM, DM, nullptr, nullptr, WKV, 0, 0, r, scr, lane); continue; } r -= I_SQ;
            if (r < I_SQ) { tr_job(INF(20), DM, DM, nullptr, nullptr, WKV, 2048, 0, r, scr, lane); continue; } r -= I_SQ;
            tr_job(INF(21), DM, DM, nullptr, nullptr, WO, 0, 0, r, scr, lane);
        }
        for (int m = gw; m < S_; m += NGW) {
            const f32x4* xr = (const f32x4*)(x + (size_t)m * DM) + lane; float s = 0.f; v2u* o8 = (v2u*)(XN + (size_t)m * DM) + lane;
#pragma unroll
            for (int j = 0; j < 8; ++j) { const f32x4 v = xr[64 * j]; s += (v[0] * v[0] + v[1] * v[1]) + (v[2] * v[2] + v[3] * v[3]); v2u w; w.x = pk2(v[0], v[1]); w.y = pk2(v[2], v[3]); o8[64 * j] = w; }
            s = wave_sum(s); if (lane == 0) SS[SS_X * S_ + m] = s;
        }
        for (int m = gw; m < NMEM; m += NGW) {
            const f32x4* xr = (const f32x4*)(mem + (size_t)m * DM) + lane; const f32x4* gr = (const f32x4*)(INF(17)) + lane; float s = 0.f; f32x4 v[8];
#pragma unroll
            for (int j = 0; j < 8; ++j) { v[j] = xr[64 * j]; s += (v[j][0] * v[j][0] + v[j][1] * v[j][1]) + (v[j][2] * v[j][2] + v[j][3] * v[j][3]); }
            const float rs = 1.0f / sqrtf(wave_sum(s) * (1.0f / DM) + 1e-6f); v2u* o8 = (v2u*)(MK + (size_t)m * DM) + lane;
#pragma unroll
            for (int j = 0; j < 8; ++j) { const f32x4 g = gr[64 * j]; v2u w; w.x = pk2(v[j][0] * rs * g[0], v[j][1] * rs * g[1]); w.y = pk2(v[j][2] * rs * g[2], v[j][3] * rs * g[3]); o8[64 * j] = w; }
        }
        for (int i = gt; i < (SS_N - 1) * S_; i += NGT) SS[S_ + i] = 0.f;
        for (int i = gt; i < S_ * 32; i += NGT) {
            const int row = i >> 5, dd = i & 31; const double xx = (double)positions[row] * INVF[dd];
            const double kq = __builtin_rint(xx * 0.6366197723675814);
            double rr = __builtin_fma(-kq, 1.5707963267948966, xx); rr = __builtin_fma(-kq, 6.123233995736766e-17, rr);
            const int q = ((int)kq) & 3; const double r2 = rr * rr;
            double sn = -1.0 / 1307674368000.0; sn = sn * r2 + 1.0 / 6227020800.0; sn = sn * r2 - 1.0 / 39916800.0; sn = sn * r2 + 1.0 / 362880.0; sn = sn * r2 - 1.0 / 5040.0; sn = sn * r2 + 1.0 / 120.0; sn = sn * r2 - 1.0 / 6.0; sn = sn * r2 + 1.0; sn *= rr;
            double cs = 1.0 / 20922789888000.0; cs = cs * r2 - 1.0 / 87178291200.0; cs = cs * r2 + 1.0 / 479001600.0; cs = cs * r2 - 1.0 / 3628800.0; cs = cs * r2 + 1.0 / 40320.0; cs = cs * r2 - 1.0 / 720.0; cs = cs * r2 + 1.0 / 24.0; cs = cs * r2 - 0.5; cs = cs * r2 + 1.0;
            const double sv = (q == 0) ? sn : (q == 1) ? cs : (q == 2) ? -sn : -cs;
            const double cv = (q == 0) ? cs : (q == 1) ? -sn : (q == 2) ? -cs : sn;
            cosT[i] = (float)cv; sinT[i] = (float)sv;
        }
    }
    SEAM(0);

    if (IN(1)) {
        pg8::Gemm g{XN, WGU1, S_, 2 * DFF, DM}; pg8::StaticOrder S; S.init(S_, 2 * DFF, G, bx);
        pg8::EpiSwiglu E{HB, DFF, SS + SS_X * S_, 1.0f / DM};
        pg8::gemm_phase<pg8::EpiSwiglu, pg8::StaticOrder, true, true>(lds, g, S, E);
    }
    SEAM(1);
    if (IN(2)) {
        pg8::Gemm g{HB, WD1, S_, DM, DFF}; pg8::StaticOrder S; S.init(S_, DM, G, bx);
        pg8::EpiResid<false> E{x, HRES, XN, SS + SS_H1 * S_, nullptr, 0.f, 0.5f, nullptr};
        pg8::gemm_phase<pg8::EpiResid<false>, pg8::StaticOrder, true, true>(lds, g, S, E);
    }
    SEAM(2);
    if (IN(3)) {
        { pg8::Gemm g{XN, WIN, S_, DIN, DM}; pg8::StaticOrder S; S.init(S_, DIN, G, bx);
          pg8::EpiWin E{Qb, (size_t)(8u << 20), SS + SS_H1 * S_, 1.0f / DM, cosT, sinT, SS + LN_S1 * S_, SS + LN_S2 * S_};
          pg8::gemm_phase<pg8::EpiWin, pg8::StaticOrder, true, true>(lds, g, S, E); }
        { pg8::Gemm g{MK, WKV, NMEM, 2 * DM, DM}; pg8::StaticOrder S; S.init(NMEM, 2 * DM, G, (bx + G / 2) % G);
          pg8::EpiBf16Scale E{KVM, 2 * DM, nullptr, 0.f};
          pg8::gemm_phase<pg8::EpiBf16Scale, pg8::StaticOrder, true, true>(lds, g, S, E); }
    }
    SEAM(3);
    if (IN(4)) {
#if USE_MFMA_ATTN
        dattn_mfma(lds, Qb, Kb, Vb, OBb, LSEb, bx, G, tid, wave, lane);
#else
        attn_naive(lds, Qb, Kb, Vb, MIXED, SS + SS_A * S_, gw, NGW, wave, lane);
        __syncthreads();
#endif
#if USE_MFMA_SGU
        sgu_mfma(lds, Ub, GVb, SS + LN_S1 * S_, SS + LN_S2 * S_, (const float*)args.in[9], (const float*)args.in[10], (const float*)args.in[11], (const float*)args.in[12], MIXED, SS + SS_S * S_, bx, G, tid, wave, lane);
#else
        sgu_naive(lds, Ub, GVb, SS + LN_S1 * S_, SS + LN_S2 * S_, (const float*)args.in[9], (const float*)args.in[10], (const float*)args.in[11], (const float*)args.in[12], MIXED, SS + SS_S * S_, bx, G, tid, lane);
#endif
    }
    SEAM(4);
    if (IN(5)) {
        for (int m = gw; m < S_; m += NGW) {
            const float rsg = 1.0f / sqrtf(SS[SS_S * S_ + m] * (1.0f / AW) + 1e-6f);
            v4u* p = (v4u*)(MIXED + (size_t)m * DM) + lane;
#if USE_MFMA_ATTN
            float val[2][8]; float ssq = 0.f;
#pragma unroll
            for (int j = 0; j < 2; ++j) { const int c = lane + 64 * j, hh = c >> 3;
                const float l0 = LSEb[((size_t)0 * S_ + m) * 16 + hh], l1 = LSEb[((size_t)1 * S_ + m) * 16 + hh], l2 = LSEb[((size_t)2 * S_ + m) * 16 + hh];
                const float mx = fmaxf(l0, fmaxf(l1, l2)); float w0 = __builtin_amdgcn_exp2f(l0 - mx), w1 = __builtin_amdgcn_exp2f(l1 - mx), w2 = __builtin_amdgcn_exp2f(l2 - mx);
                const float inv = 1.0f / (w0 + w1 + w2); w0 *= inv; w1 *= inv; w2 *= inv;
                const bf16x8 a0 = *(const bf16x8*)(OBb + ((size_t)0 * S_ + m) * AW + 8 * c), a1 = *(const bf16x8*)(OBb + ((size_t)1 * S_ + m) * AW + 8 * c), a2 = *(const bf16x8*)(OBb + ((size_t)2 * S_ + m) * AW + 8 * c);
#pragma unroll
                for (int e = 0; e < 8; ++e) { const float v = w0 * bf2f((unsigned short)a0[e]) + w1 * bf2f((unsigned short)a1[e]) + w2 * bf2f((unsigned short)a2[e]); val[j][e] = v; ssq += v * v; } }
            const float ra = 1.0f / sqrtf(wave_sum(ssq) * (1.0f / AW) + 1e-6f);
#pragma unroll
            for (int j = 0; j < 2; ++j) { v4u w; w.x = pk2(val[j][0] * ra, val[j][1] * ra); w.y = pk2(val[j][2] * ra, val[j][3] * ra); w.z = pk2(val[j][4] * ra, val[j][5] * ra); w.w = pk2(val[j][6] * ra, val[j][7] * ra); p[64 * j] = w; }
#else
            const float ra = 1.0f / sqrtf(SS[SS_A * S_ + m] * (1.0f / AW) + 1e-6f);
#endif
#pragma unroll
            for (int j = (USE_MFMA_ATTN ? 2 : 0); j < 4; ++j) { v4u w = p[64 * j]; const float sc = j < 2 ? ra : rsg;
                w.x = pk2(bf2f((unsigned short)(w.x & 0xffff)) * sc, bf2f((unsigned short)(w.x >> 16)) * sc); w.y = pk2(bf2f((unsigned short)(w.y & 0xffff)) * sc, bf2f((unsigned short)(w.y >> 16)) * sc);
                w.z = pk2(bf2f((unsigned short)(w.z & 0xffff)) * sc, bf2f((unsigned short)(w.z >> 16)) * sc); w.w = pk2(bf2f((unsigned short)(w.w & 0xffff)) * sc, bf2f((unsigned short)(w.w >> 16)) * sc);
                p[64 * j] = w; }
        }
    }
    SEAM(5);
    if (IN(6)) {
        pg8::Gemm g{MIXED, WOUT, S_, DM, DM}; pg8::StaticOrder S; S.init(S_, DM, G, bx);
        pg8::EpiResid<false> E{HRES, HRES, XN, SS + SS_H2 * S_, nullptr, 0.f, 1.0f, nullptr};
        pg8::gemm_phase<pg8::EpiResid<false>, pg8::StaticOrder, true, true>(lds, g, S, E);
    }
    SEAM(6);
    if (IN(7)) {
        pg8::Gemm g{XN, WQ, S_, DM, DM}; pg8::StaticOrder S; S.init(S_, DM, G, bx);
        pg8::EpiBf16Scale E{QM, DM, SS + SS_H2 * S_, 1.0f / DM};
        pg8::gemm_phase<pg8::EpiBf16Scale, pg8::StaticOrder, true, true>(lds, g, S, E);
    }
    SEAM(7);
    if (IN(8)) {
#if USE_MFMA_XATTN
        xattn_mfma(lds, QM, KVM, OM, bx, G, tid, wave, lane);
#else
        xattn_naive(lds, QM, KVM, OM, gw, NGW, wave, lane);
#endif
    }
    SEAM(8);
    if (IN(9)) {
        pg8::Gemm g{OM, WO, S_, DM, DM}; pg8::StaticOrder S; S.init(S_, DM, G, bx);
        pg8::EpiResid<false> E{HRES, HRES, XN, SS + SS_H3 * S_, nullptr, 0.f, 1.0f, nullptr};
        pg8::gemm_phase<pg8::EpiResid<false>, pg8::StaticOrder, true, true>(lds, g, S, E);
    }
    SEAM(9);
    if (IN(10)) {
        pg8::Gemm g{XN, WGU2, S_, 2 * DFF, DM}; pg8::StaticOrder S; S.init(S_, 2 * DFF, G, bx);
        pg8::EpiSwiglu E{HB, DFF, SS + SS_H3 * S_, 1.0f / DM};
        pg8::gemm_phase<pg8::EpiSwiglu, pg8::StaticOrder, true, true>(lds, g, S, E);
    }
    SEAM(10);
    if (IN(11)) {
        pg8::Gemm g{HB, WD2, S_, DM, DFF}; pg8::StaticOrder S; S.init(S_, DM, G, bx);
        pg8::EpiResid<false> E{HRES, HRES, nullptr, SS + SS_H4 * S_, nullptr, 0.f, 0.5f, nullptr};
        pg8::gemm_phase<pg8::EpiResid<false>, pg8::StaticOrder, true, true>(lds, g, S, E);
    }
    SEAM(11);
    if (IN(12)) {
        const float* fg = (const float*)args.in[26];
        for (int m = gw; m < S_; m += NGW) {
            f32x4* xr = (f32x4*)(HRES + (size_t)m * DM) + lane; const f32x4* gr = (const f32x4*)fg + lane;
            const float rs = 1.0f / sqrtf(SS[SS_H4 * S_ + m] * (1.0f / DM) + 1e-6f);
#pragma unroll
            for (int j = 0; j < 8; ++j) { f32x4 v = xr[64 * j]; const f32x4 g = gr[64 * j]; v = v * rs * g; xr[64 * j] = v; }
        }
    }
#undef IN
#undef SEAM
}

constexpr int NPH = 13;
extern "C" void kernel_launch(void* const* d_in, const int* in_sizes, int n_in, void* d_out, int out_size, void* d_ws, size_t ws_size, hipStream_t stream) {
    static int grid = 0;
    if (grid == 0) {
        if (n_in != 27 || out_size != S_ * DM || ws_size < WS_END) { fprintf(stderr, "kernel_launch: unexpected problem (n_in %d out %d ws %zu)\n", n_in, out_size, ws_size); grid = -1; return; }
        int dev = 0, cus = 0, per_cu = 0;
        hipGetDevice(&dev); hipDeviceGetAttribute(&cus, hipDeviceAttributeMultiprocessorCount, dev);
        hipFuncSetAttribute((const void*)mega_fwd, hipFuncAttributeMaxDynamicSharedMemorySize, LDS_BYTES);
        hipOccupancyMaxActiveBlocksPerMultiprocessor(&per_cu, (const void*)mega_fwd, NWAVES * 64, LDS_BYTES);
        if (per_cu < 1) per_cu = 1;
        (void)hipGetLastError();
        grid = cus * 1;
        fprintf(stderr, "kernel_launch: cus %d per_cu %d grid %d\n", cus, per_cu, grid);
    }
    if (grid < 0) return;
    Args a{};
    for (int i = 0; i < 27; ++i) a.in[i] = d_in[i];
    a.out = (float*)d_out; a.ws = (unsigned char*)d_ws; a.ph_lo = 0; a.ph_hi = NPH;
    void* kargs[] = {&a};
    hipError_t e = hipLaunchCooperativeKernel((const void*)mega_fwd, dim3(grid), dim3(NWAVES * 64), kargs, LDS_BYTES, stream);
    if (e != hipSuccess) fprintf(stderr, "cooperative launch failed: %s (grid %d)\n", hipGetErrorString(e), grid);
}
```

```cpp
#include <hip/hip_runtime.h>
#include <hip/hip_cooperative_groups.h>
#include <cstdio>
#include <cstdint>
#include <cmath>
namespace cg = cooperative_groups;
namespace pg8 {
#define PG8_LAS __attribute__((address_space(3)))
typedef unsigned short bf16_t;
typedef short bf16x8 __attribute__((ext_vector_type(8)));
typedef float f32x4 __attribute__((ext_vector_type(4)));
typedef unsigned u32x4 __attribute__((ext_vector_type(4)));
constexpr int BM = 256, BK = 64, HALF = 128, HTB = HALF * BK * 2  , STAGE_BYTES = 8 * HTB, NXCD = 8, WGM = 8;

__host__ __device__ __forceinline__ int lds_byte(int r, int c) { const int st = (r >> 4) * 2 + (c >> 5), rr = r & 15, cc = c & 31, ob = rr * 64 + cc * 2; return st * 1024 + (ob ^ (((ob >> 9) & 1) << 5)); }
__host__ __device__ __forceinline__ void stage_rc(int b, int& R, int& C) { const int st = b / 1024, sb = b % 1024, swz = sb ^ (((sb >> 9) & 1) << 5); R = (st >> 1) * 16 + swz / 64; C = (st & 1) * 32 + (swz % 64) / 2; }
__host__ __device__ __forceinline__ int perm32(int rho) { const int n = rho >> 4, i = rho & 15; return 8 * (i >> 2) + 4 * n + (i & 3); }

struct Unit { int pm, pn; };
struct Gemm { const bf16_t* A; const bf16_t* Bt; int M, N, K; };

struct StaticOrder {
    int nM, nN, nwg, G, c;
    __host__ __device__ void init(int M, int N, int G_, int c_) { nM = M / BM; nN = N / BM; nwg = nM * nN; G = G_; c = c_; }
    __host__ __device__ bool next(int i, Unit& u) const {
        const long L = (long)i * G + c; if (L >= nwg) return false;
        int wgid = (int)L; { const int q = nwg / NXCD, r = nwg % NXCD, xcd = wgid % NXCD, off = wgid / NXCD; wgid = (xcd < r ? xcd * (q + 1) : r * (q + 1) + (xcd - r) * q) + off; }
        const int nig = WGM * nN, gid = wgid / nig, fm = gid * WGM, gsz = (nM - fm) < WGM ? (nM - fm) : WGM;
        u.pm = fm + ((wgid % nig) % gsz); u.pn = (wgid % nig) / gsz; return true;
    }
    __device__ __forceinline__ void a_ready(const Unit&) const {}
    __device__ __forceinline__ void done(const Unit&) const {}
};

__device__ __forceinline__ unsigned cvt_pk_bf16(float lo, float hi) { unsigned r; asm volatile("v_cvt_pk_bf16_f32 %0, %1, %2" : "=v"(r) : "v"(lo), "v"(hi)); return r; }
typedef float f32x2 __attribute__((ext_vector_type(2)));
constexpr float NEPS = 1e-6f;
__device__ __forceinline__ float fast_sigmoid(float z) { return __builtin_amdgcn_rcpf(1.0f + __builtin_amdgcn_exp2f(-1.4426950408889634f * z)); }
__device__ __forceinline__ float silu_f(float x) { return x * fast_sigmoid(x); }
__device__ __forceinline__ float gelu_tanh_f(float x) { const float z = 1.5957691216057308f * (x + 0.044715f * x * x * x); return x * fast_sigmoid(z); }
__device__ __forceinline__ u32x4 pack8(const f32x4 a, const f32x4 b) { u32x4 w; w.x = cvt_pk_bf16(a[0], a[1]); w.y = cvt_pk_bf16(a[2], a[3]); w.z = cvt_pk_bf16(b[0], b[1]); w.w = cvt_pk_bf16(b[2], b[3]); return w; }

struct EpiSwiglu {
    static constexpr bool PERM = true, AFTER_DRAIN = false, MID = false;
    bf16_t* H; int ldh; const float* ss; float invw;
    __device__ __forceinline__ void operator()(const f32x4 (&acc)[2][2][4][2], const Unit& u, int wr, int wc, int fr, int fq) const {
        const int row0 = u.pm * BM + wr * 64 + fr, col0 = u.pn * HALF + wc * 32 + 8 * fq;
#pragma unroll
        for (int ai = 0; ai < 2; ++ai)
#pragma unroll
            for (int m = 0; m < 4; ++m) { const int r = row0 + ai * HALF + m * 16; const float rs = __builtin_amdgcn_rsqf(ss[r] * invw + NEPS);
                f32x4 h0, h1;
#pragma unroll
                for (int j = 0; j < 4; ++j) { h0[j] = silu_f(acc[ai][0][m][0][j] * rs) * (acc[ai][1][m][0][j] * rs); h1[j] = silu_f(acc[ai][0][m][1][j] * rs) * (acc[ai][1][m][1][j] * rs); }
                *(u32x4*)(H + (size_t)r * ldh + col0) = pack8(h0, h1); }
    }
};

template <bool HAS_MID> struct EpiResid {
    static constexpr bool PERM = true, AFTER_DRAIN = false, MID = HAS_MID;
    const float* base; float* out; bf16_t* xn; float* ss_out; const float* ss_in; float invw_in; float alpha; const float* ss_mid;
    __device__ __forceinline__ void mid(f32x4 (&acc)[2][2][4][2], const Unit& u, int wr, int fr) const {
        const int row0 = u.pm * BM + wr * 64 + fr;
#pragma unroll
        for (int ai = 0; ai < 2; ++ai)
#pragma unroll
            for (int m = 0; m < 4; ++m) { const int r = row0 + ai * HALF + m * 16;
                const float ratio = __builtin_amdgcn_rsqf(ss_mid[r] * invw_in + NEPS) * __builtin_sqrtf(ss_in[r] * invw_in + NEPS);
#pragma unroll
                for (int bj = 0; bj < 2; ++bj)
#pragma unroll
                    for (int n = 0; n < 2; ++n) acc[ai][bj][m][n] = acc[ai][bj][m][n] * ratio; }
    }
    __device__ __forceinline__ void operator()(const f32x4 (&acc)[2][2][4][2], const Unit& u, int wr, int wc, int fr, int fq) const {
        const int row0 = u.pm * BM + wr * 64 + fr, col0 = u.pn * BM + wc * 32 + 8 * fq;
#pragma unroll
        for (int ai = 0; ai < 2; ++ai)
#pragma unroll
            for (int m = 0; m < 4; ++m) { const int r = row0 + ai * HALF + m * 16;
                float sc = alpha; if (ss_in) sc *= __builtin_amdgcn_rsqf(ss_in[r] * invw_in + NEPS);
                float q = 0.f;
#pragma unroll
                for (int bj = 0; bj < 2; ++bj) { const size_t off = (size_t)r * 2048 + col0 + bj * HALF;
                    const f32x4 b0 = *(const f32x4*)(base + off), b1 = *(const f32x4*)(base + off + 4);
                    const f32x4 o0 = b0 + acc[ai][bj][m][0] * sc, o1 = b1 + acc[ai][bj][m][1] * sc;
                    *(f32x4*)(out + off) = o0; *(f32x4*)(out + off + 4) = o1;
                    q += (o0[0] * o0[0] + o0[1] * o0[1]) + (o0[2] * o0[2] + o0[3] * o0[3]) + (o1[0] * o1[0] + o1[1] * o1[1]) + (o1[2] * o1[2] + o1[3] * o1[3]);
                    if (xn) *(u32x4*)(xn + off) = pack8(o0, o1); }
                q += __shfl_xor(q, 16); q += __shfl_xor(q, 32);
                if (fq == 0) atomicAdd(ss_out + r, q); }
    }
};

struct EpiBf16Scale {
    static constexpr bool PERM = true, AFTER_DRAIN = false, MID = false;
    bf16_t* O; int ldc; const float* ss; float invw;
    __device__ __forceinline__ void operator()(const f32x4 (&acc)[2][2][4][2], const Unit& u, int wr, int wc, int fr, int fq) const {
        const int row0 = u.pm * BM + wr * 64 + fr, col0 = u.pn * BM + wc * 32 + 8 * fq;
#pragma unroll
        for (int ai = 0; ai < 2; ++ai)
#pragma unroll
            for (int m = 0; m < 4; ++m) { const int r = row0 + ai * HALF + m * 16; const float rs = ss ? __builtin_amdgcn_rsqf(ss[r] * invw + NEPS) : 1.0f;
#pragma unroll
                for (int bj = 0; bj < 2; ++bj) *(u32x4*)(O + (size_t)r * ldc + col0 + bj * HALF) = pack8(acc[ai][bj][m][0] * rs, acc[ai][bj][m][1] * rs); }
    }
};

struct EpiWin {
    static constexpr bool PERM = true, AFTER_DRAIN = false, MID = false;
    bf16_t* QKVUG; size_t rstride; const float* ss; float invw; const float* cosT; const float* sinT; float* ln_s1; float* ln_s2;
    __device__ __forceinline__ void operator()(const f32x4 (&acc)[2][2][4][2], const Unit& u, int wr, int wc, int fr, int fq) const {
        const int reg = u.pn >> 2, cc = (u.pn & 3) * BM, row0 = u.pm * BM + wr * 64 + fr;
        if (reg < 2) {
            bf16_t* O = QKVUG + (size_t)reg * rstride;
#pragma unroll
            for (int ai = 0; ai < 2; ++ai)
#pragma unroll
                for (int m = 0; m < 4; ++m) { const int r = row0 + ai * HALF + m * 16; const float rs = __builtin_amdgcn_rsqf(ss[r] * invw + NEPS);
                    const f32x4 c0 = *(const f32x4*)(cosT + (size_t)r * 32 + 8 * fq), c1 = *(const f32x4*)(cosT + (size_t)r * 32 + 8 * fq + 4);
                    const f32x4 s0 = *(const f32x4*)(sinT + (size_t)r * 32 + 8 * fq), s1 = *(const f32x4*)(sinT + (size_t)r * 32 + 8 * fq + 4);
                    const f32x4 a0 = acc[ai][0][m][0] * rs, a1 = acc[ai][0][m][1] * rs, b0 = acc[ai][1][m][0] * rs, b1 = acc[ai][1][m][1] * rs;
                    const f32x4 lo0 = a0 * c0 - b0 * s0, lo1 = a1 * c1 - b1 * s1, hi0 = a0 * s0 + b0 * c0, hi1 = a1 * s1 + b1 * c1;
                    bf16_t* p = O + (size_t)r * 1024 + cc + 64 * wc + 8 * fq;
                    *(u32x4*)p = pack8(lo0, lo1); *(u32x4*)(p + 32) = pack8(hi0, hi1); }
        } else {
            bf16_t* O = QKVUG + (size_t)reg * rstride;
#pragma unroll
            for (int ai = 0; ai < 2; ++ai)
#pragma unroll
                for (int m = 0; m < 4; ++m) { const int r = row0 + ai * HALF + m * 16; const float rs = __builtin_amdgcn_rsqf(ss[r] * invw + NEPS);
                    float s1 = 0.f, s2 = 0.f;
#pragma unroll
                    for (int bj = 0; bj < 2; ++bj) { f32x4 v0 = acc[ai][bj][m][0] * rs, v1 = acc[ai][bj][m][1] * rs;
                        if (reg >= 3) {
#pragma unroll
                            for (int j = 0; j < 4; ++j) { v0[j] = gelu_tanh_f(v0[j]); v1[j] = gelu_tanh_f(v1[j]); } }
                        if (reg == 4) { s1 += (v0[0] + v0[1]) + (v0[2] + v0[3]) + (v1[0] + v1[1]) + (v1[2] + v1[3]);
                            s2 += (v0[0] * v0[0] + v0[1] * v0[1]) + (v0[2] * v0[2] + v0[3] * v0[3]) + (v1[0] * v1[0] + v1[1] * v1[1]) + (v1[2] * v1[2] + v1[3] * v1[3]); }
                        *(u32x4*)(O + (size_t)r * 1024 + cc + bj * HALF + 32 * wc + 8 * fq) = pack8(v0, v1); }
                    if (reg == 4) { s1 += __shfl_xor(s1, 16); s1 += __shfl_xor(s1, 32); s2 += __shfl_xor(s2, 16); s2 += __shfl_xor(s2, 32);
                        if (fq == 0) { atomicAdd(ln_s1 + r, s1); atomicAdd(ln_s2 + r, s2); } } }
        }
    }
};
template <class Epi, class Sched, bool ALIGN_EPI = false, bool SP2 = false>
__device__ __forceinline__ void gemm_phase(PG8_LAS unsigned char* lds, const Gemm g, const Sched& S, const Epi& E) {
    const int tid = threadIdx.x, wid = __builtin_amdgcn_readfirstlane(tid >> 6), lane = tid & 63, wr = wid >> 2, wc = wid & 3, fr = lane & 15, fq = lane >> 4;
    const int K = g.K, nt = K / BK;
    unsigned voffA[2], voffB[2];
#pragma unroll
    for (int i = 0; i < 2; ++i) { int R, C; stage_rc(tid * 16 + i * 8192, R, C); const int Rb = Epi::PERM ? ((R & ~31) + perm32(R & 31)) : R;
        voffA[i] = (unsigned)(R * K + C) * 2u; voffB[i] = (unsigned)(Rb * K + C) * 2u; }
    const size_t kstep = (size_t)(BK * 2);
    const size_t hstep = (size_t)HALF * K * 2;
    const size_t tstep = 2 * hstep;
    const unsigned ldsw = (unsigned)wid * 1024u;
    const int aoff = lds_byte(wr * 64 + fr, fq * 8), boff = lds_byte(wc * 32 + fr, fq * 8);
#define PG8_SA(b, h) (((b) * 2 + (h)) * HTB)
#define PG8_SB(b, h) ((4 + (b) * 2 + (h)) * HTB)
#define PG8_STAGE(bufoff, gbase, voff) do { _Pragma("unroll") for (int _i = 0; _i < 2; ++_i) \
        __builtin_amdgcn_global_load_lds((const unsigned*)((const char*)(gbase) + (voff)[_i]), (PG8_LAS unsigned*)(lds + (bufoff) + ldsw + _i * 8192), 16, 0, 0); } while (0)
#define PG8_LDA(dst, b, h) do { _Pragma("unroll") for (int m = 0; m < 4; ++m) _Pragma("unroll") for (int k = 0; k < 2; ++k) dst[m][k] = *(const PG8_LAS bf16x8*)(lds + PG8_SA(b, h) + aoff + m * 2048 + k * 1024); } while (0)
#define PG8_LDB(dst, b, h) do { _Pragma("unroll") for (int n = 0; n < 2; ++n) _Pragma("unroll") for (int k = 0; k < 2; ++k) dst[n][k] = *(const PG8_LAS bf16x8*)(lds + PG8_SB(b, h) + boff + n * 2048 + k * 1024); } while (0)
#define PG8_MMA(ai, bj, At, Bt) do { __builtin_amdgcn_s_setprio(1); _Pragma("unroll") for (int m = 0; m < 4; ++m) _Pragma("unroll") for (int n = 0; n < 2; ++n) _Pragma("unroll") for (int k = 0; k < 2; ++k) \
        acc[ai][bj][m][n] = __builtin_amdgcn_mfma_f32_16x16x32_bf16(Bt[n][k], At[m][k], acc[ai][bj][m][n], 0, 0, 0); __builtin_amdgcn_s_setprio(0); } while (0)
#define PG8_WAIT_V(n) asm volatile("s_waitcnt vmcnt(" #n ")" ::: "memory")
#define PG8_WAIT_L(n) asm volatile("s_waitcnt lgkmcnt(" #n ")" ::: "memory")
#define PG8_BAR __builtin_amdgcn_s_barrier()
#define PG8_SCHED __builtin_amdgcn_sched_barrier(0)
    Unit cur, nxt; int ui = 0;
    if (!S.next(0, cur)) return;
    f32x4 acc[2][2][4][2];
#pragma unroll
    for (int a = 0; a < 2; ++a)
#pragma unroll
        for (int b = 0; b < 2; ++b)
#pragma unroll
            for (int m = 0; m < 4; ++m)
#pragma unroll
                for (int n = 0; n < 2; ++n) acc[a][b][m][n] = (f32x4){0.f, 0.f, 0.f, 0.f};
    bf16x8 At[4][2], B0[2][2], B1[2][2];
    const char* cA = (const char*)g.A + (size_t)cur.pm * tstep; const char* cB = (const char*)g.Bt + (size_t)cur.pn * tstep;
    S.a_ready(cur);
    if constexpr (SP2) {
        PG8_STAGE(PG8_SB(0, 0), cB, voffB); PG8_STAGE(PG8_SB(0, 1), cB + hstep, voffB); PG8_STAGE(PG8_SA(0, 0), cA, voffA); PG8_STAGE(PG8_SA(0, 1), cA + hstep, voffA);
        if (wr == 1) PG8_BAR;
        PG8_WAIT_V(2); PG8_BAR;
        PG8_STAGE(PG8_SB(1, 0), cB + kstep, voffB); PG8_STAGE(PG8_SA(1, 0), cA + kstep, voffA); PG8_STAGE(PG8_SB(1, 1), cB + hstep + kstep, voffB);
        PG8_WAIT_V(6); PG8_BAR;
    } else {
        PG8_STAGE(PG8_SB(0, 0), cB, voffB); PG8_STAGE(PG8_SA(0, 0), cA, voffA); PG8_STAGE(PG8_SB(0, 1), cB + hstep, voffB); PG8_STAGE(PG8_SA(0, 1), cA + hstep, voffA);
        if (wr == 1) PG8_BAR;
        PG8_WAIT_V(4); PG8_BAR;
        PG8_STAGE(PG8_SB(1, 0), cB + kstep, voffB); PG8_STAGE(PG8_SA(1, 0), cA + kstep, voffA); PG8_STAGE(PG8_SB(1, 1), cB + hstep + kstep, voffB);
        PG8_WAIT_V(6); PG8_BAR;
    }
    for (;;) {
        const bool has_next = S.next(ui + 1, nxt);
        const char* nA = has_next ? (const char*)g.A + (size_t)nxt.pm * tstep : cA; const char* nB = has_next ? (const char*)g.Bt + (size_t)nxt.pn * tstep : cB;
        for (int t = 0; t < nt; t += 2) {
            if constexpr (Epi::MID) { if (t == (nt >> 1)) E.mid(acc, cur, wr, fr); }
            const bool last = (t == nt - 2);
            const char* a1 = cA + (size_t)(t + 1) * kstep;
            const char* a2 = last ? nA : cA + (size_t)(t + 2) * kstep; const char* b2 = last ? nB : cB + (size_t)(t + 2) * kstep;
            const char* a3 = a2 + kstep; const char* b3 = b2 + kstep;
            if (last && has_next) S.a_ready(nxt);
            if constexpr (SP2) {
            PG8_LDB(B0, 0, 0); PG8_LDB(B1, 0, 1); PG8_SCHED; PG8_LDA(At, 0, 0); PG8_STAGE(PG8_SA(1, 1), a1 + hstep, voffA);
            PG8_WAIT_V(8); PG8_WAIT_L(0); PG8_BAR; PG8_MMA(0, 0, At, B0); PG8_MMA(0, 1, At, B1); PG8_BAR; PG8_SCHED;
            PG8_LDA(At, 0, 1); PG8_STAGE(PG8_SB(0, 0), b2, voffB); PG8_STAGE(PG8_SB(0, 1), b2 + hstep, voffB); PG8_STAGE(PG8_SA(0, 0), a2, voffA);
            PG8_WAIT_V(8); PG8_WAIT_L(0); PG8_BAR; PG8_MMA(1, 0, At, B0); PG8_MMA(1, 1, At, B1); PG8_BAR; PG8_SCHED;
            PG8_LDB(B0, 1, 0); PG8_LDB(B1, 1, 1); PG8_SCHED; PG8_LDA(At, 1, 0); PG8_STAGE(PG8_SA(0, 1), a2 + hstep, voffA);
            PG8_WAIT_V(8); PG8_WAIT_L(0); PG8_BAR; PG8_MMA(0, 0, At, B0); PG8_MMA(0, 1, At, B1); PG8_BAR; PG8_SCHED;
            PG8_LDA(At, 1, 1); PG8_STAGE(PG8_SB(1, 0), b3, voffB); PG8_STAGE(PG8_SB(1, 1), b3 + hstep, voffB); PG8_STAGE(PG8_SA(1, 0), a3, voffA);
            PG8_WAIT_V(8); PG8_WAIT_L(0); PG8_BAR; PG8_MMA(1, 0, At, B0); PG8_MMA(1, 1, At, B1); PG8_BAR; PG8_SCHED;
            } else {
            PG8_LDB(B0, 0, 0); PG8_SCHED; PG8_LDA(At, 0, 0); PG8_STAGE(PG8_SA(1, 1), a1 + hstep, voffA);
            PG8_WAIT_L(8); PG8_BAR; PG8_WAIT_L(0); PG8_MMA(0, 0, At, B0); PG8_BAR; PG8_SCHED;
            PG8_LDB(B1, 0, 1); PG8_STAGE(PG8_SB(0, 0), b2, voffB);
            PG8_BAR; PG8_WAIT_L(0); PG8_MMA(0, 1, At, B1); PG8_BAR;
            PG8_LDA(At, 0, 1); PG8_STAGE(PG8_SA(0, 0), a2, voffA);
            PG8_BAR; PG8_WAIT_L(0); PG8_MMA(1, 0, At, B0); PG8_BAR; PG8_SCHED;
            PG8_STAGE(PG8_SB(0, 1), b2 + hstep, voffB);
            PG8_WAIT_V(6); PG8_BAR; PG8_MMA(1, 1, At, B1); PG8_BAR;
            PG8_LDB(B0, 1, 0); PG8_SCHED; PG8_LDA(At, 1, 0); PG8_STAGE(PG8_SA(0, 1), a2 + hstep, voffA);
            PG8_WAIT_L(8); PG8_BAR; PG8_WAIT_L(0); PG8_MMA(0, 0, At, B0); PG8_BAR; PG8_SCHED;
            PG8_LDB(B1, 1, 1); PG8_STAGE(PG8_SB(1, 0), b3, voffB);
            PG8_BAR; PG8_WAIT_L(0); PG8_MMA(0, 1, At, B1); PG8_BAR;
            PG8_LDA(At, 1, 1); PG8_STAGE(PG8_SA(1, 0), a3, voffA);
            PG8_BAR; PG8_WAIT_L(0); PG8_MMA(1, 0, At, B0); PG8_BAR; PG8_SCHED;
            PG8_STAGE(PG8_SB(1, 1), b3 + hstep, voffB);
            PG8_WAIT_V(6); PG8_BAR; PG8_MMA(1, 1, At, B1); PG8_BAR;
            }
        }
        if constexpr (ALIGN_EPI) { if (wr == 0) PG8_BAR; }
        if constexpr (!Epi::AFTER_DRAIN) { E(acc, cur, wr, wc, fr, fq); S.done(cur); }
        if (!has_next) break;
#pragma unroll
        for (int a = 0; a < 2; ++a)
#pragma unroll
            for (int b = 0; b < 2; ++b)
#pragma unroll
                for (int m = 0; m < 4; ++m)
#pragma unroll
                    for (int n = 0; n < 2; ++n) acc[a][b][m][n] = (f32x4){0.f, 0.f, 0.f, 0.f};
        cur = nxt; cA = nA; cB = nB; ++ui;
        if constexpr (ALIGN_EPI) { if (wr == 1) PG8_BAR; }
    }
    PG8_WAIT_V(0);
    if constexpr (!ALIGN_EPI) { if (wr == 0) PG8_BAR; }
    PG8_BAR;
    if constexpr (Epi::AFTER_DRAIN) { E.fused(acc, cur, wr, wc, fr, fq, lds, wid, lane); S.done(cur); }
#undef PG8_SA
#undef PG8_SB
#undef PG8_STAGE
#undef PG8_LDA
#undef PG8_LDB
#undef PG8_MMA
#undef PG8_WAIT_V
#undef PG8_WAIT_L
#undef PG8_BAR
#undef PG8_SCHED
}
}

constexpr int NWAVES = 8;
constexpr int S_ = 8192, DM = 2048, DFF = 5632, NMEM = 256, DIN = 5120, AW = 1024;
constexpr size_t MiB = 1u << 20;
constexpr size_t WS_CTL = 0, WS_COS = 1 * MiB, WS_SIN = 2 * MiB, WS_MK = 3 * MiB, WS_KVM = 4 * MiB;
constexpr size_t WS_WGU1 = 6 * MiB, WS_WD1 = 50 * MiB, WS_WGU2 = 72 * MiB, WS_WD2 = 116 * MiB, WS_WIN = 138 * MiB, WS_WOUT = 158 * MiB, WS_WQ = 166 * MiB, WS_WKV = 174 * MiB, WS_WO = 190 * MiB;
constexpr size_t WS_XN = 198 * MiB, WS_MIXED = 230 * MiB, WS_OB = 262 * MiB, WS_LSE = 310 * MiB, WS_ACT = 312 * MiB, WS_END = 400 * MiB;
constexpr size_t WS_Q = WS_ACT, WS_K = WS_ACT + 16 * MiB, WS_V = WS_ACT + 32 * MiB, WS_U = WS_ACT + 48 * MiB, WS_GV = WS_ACT + 64 * MiB;
constexpr size_t WS_QM = WS_ACT, WS_OM = WS_ACT + 32 * MiB;
enum { SS_X = 0, SS_H1, LN_S1, LN_S2, SS_A, SS_S, SS_H2, SS_H3, SS_H4, SS_N };
#ifndef USE_MFMA_ATTN
#define USE_MFMA_ATTN 1
#endif
#ifndef USE_MFMA_SGU
#define USE_MFMA_SGU 1
#endif
#ifndef USE_MFMA_XATTN
#define USE_MFMA_XATTN 1
#endif
constexpr int RING_BYTES = 131072, LDS_BYTES = 147456;

#define LAS __attribute__((address_space(3)))
typedef unsigned short bf16;
typedef unsigned v4u __attribute__((ext_vector_type(4)));
typedef unsigned v2u __attribute__((ext_vector_type(2)));
typedef float f32x4 __attribute__((ext_vector_type(4)));
typedef short bf16x8 __attribute__((ext_vector_type(8)));
#define LDS_WAIT() asm volatile("s_waitcnt lgkmcnt(0)" ::: "memory")
__device__ __forceinline__ unsigned f2bf(float f) { unsigned u = __builtin_bit_cast(unsigned, f); return (u + 0x7fffu + ((u >> 16) & 1u)) >> 16; }
__device__ __forceinline__ unsigned pk2(float lo, float hi) { return f2bf(lo) | (f2bf(hi) << 16); }
__device__ __forceinline__ float bf2f(unsigned short b) { return __uint_as_float((unsigned)b << 16); }
__device__ __forceinline__ float wave_sum(float v) {
#pragma unroll
    for (int o = 1; o < 64; o <<= 1) v += __shfl_xor(v, o);
    return v;
}
__device__ __forceinline__ float wave_max(float v) {
#pragma unroll
    for (int o = 1; o < 64; o <<= 1) v = fmaxf(v, __shfl_xor(v, o));
    return v;
}

__constant__ double INVF[32] = {1.0, 0.7498942093324559, 0.5623413251903491, 0.4216965034285822, 0.31622776601683794, 0.23713737056616552, 0.1778279410038923, 0.1333521432163324, 0.1, 0.07498942093324558, 0.05623413251903491, 0.042169650342858224, 0.03162277660168379, 0.023713737056616554, 0.01778279410038923, 0.01333521432163324, 0.01, 0.007498942093324558, 0.005623413251903491, 0.004216965034285823, 0.0031622776601683794, 0.0023713737056616554, 0.0017782794100389228, 0.001333521432163324, 0.001, 0.0007498942093324559, 0.0005623413251903491, 0.00042169650342858224, 0.00031622776601683794, 0.00023713737056616554, 0.00017782794100389227, 0.0001333521432163324};

struct Args { const void* in[27]; float* out; unsigned char* ws; int ph_lo, ph_hi; };

__device__ __forceinline__ int dst_row(int mode, int row_off, int n) {
    if (mode == 1 || mode == 2) return (n >> 7) * 256 + (mode == 2 ? 128 : 0) + (n & 127);
    if (mode == 3 && n < 2048) return (n >> 8) * 256 + ((n >> 5) & 1) * 128 + ((n >> 6) & 3) * 32 + (n & 31);
    return row_off + n;
}
__device__ __forceinline__ void tr_job(const float* W, int K, int N, const float* g1, const float* g2, bf16* WT, int row_off, int mode, int item, LAS float* scr, int lane) {
    const int nblk = N / 64, kb = item / nblk, nb = item % nblk, k0 = 64 * kb, n0 = 64 * nb;
    const float* gain = g1; if (g2 && k0 >= 1024) gain = g2 - 1024;
    f32x4 v[16];
    const int kl = lane >> 4, n4 = (lane & 15) * 4;
#pragma unroll
    for (int i = 0; i < 16; ++i) v[i] = *(const f32x4*)(W + (size_t)(k0 + 4 * i + kl) * N + n0 + n4);
    if (gain) {
#pragma unroll
        for (int i = 0; i < 16; ++i) v[i] = v[i] * gain[k0 + 4 * i + kl];
    }
#pragma unroll
    for (int i = 0; i < 16; ++i) { const int k = 4 * i + kl; *(LAS f32x4*)(scr + k * 68 + (n4 ^ (((k >> 3) & 7) << 2))) = v[i]; }
    LDS_WAIT(); asm volatile("" ::: "memory");
    const int c = lane & 7, nn = lane >> 3;
#pragma unroll
    for (int j = 0; j < 8; ++j) { const int n = nn + 8 * j; const LAS float* sp = scr + (8 * c) * 68 + (n ^ (c << 2));
        v4u o; o.x = pk2(sp[0 * 68], sp[1 * 68]); o.y = pk2(sp[2 * 68], sp[3 * 68]); o.z = pk2(sp[4 * 68], sp[5 * 68]); o.w = pk2(sp[6 * 68], sp[7 * 68]);
        *(v4u*)(WT + (size_t)dst_row(mode, row_off, n0 + n) * K + k0 + 8 * c) = o; }
    LDS_WAIT(); asm volatile("" ::: "memory");
}

__device__ __forceinline__ void attn_naive(LAS unsigned char* lds, const bf16* Q, const bf16* K, const bf16* V, bf16* MIXED, float* ss_a, int gw, int NGW, int wave, int lane) {
    LAS float* qs = (LAS float*)lds + wave * 64;
    for (int wu = gw; wu < S_ * 16; wu += NGW) {
        const int t = wu >> 4, h = wu & 15;
        qs[lane] = bf2f(Q[(size_t)t * AW + h * 64 + lane]);
        LDS_WAIT(); asm volatile("" ::: "memory");
        float sc[9];
#pragma unroll
        for (int b = 0; b < 3; ++b)
#pragma unroll
            for (int p = 0; p < 3; ++p) {
                const int diff = 64 * p + lane, kt = t - (diff << (2 * b)); const bool valid = (diff <= 128) && (kt >= 0);
                float dot = 0.f;
                if (valid) { const bf16x8* kr = (const bf16x8*)(K + (size_t)kt * AW + h * 64);
#pragma unroll
                    for (int c = 0; c < 8; ++c) { const bf16x8 kv = kr[c];
#pragma unroll
                        for (int e = 0; e < 8; ++e) dot += qs[8 * c + e] * bf2f((unsigned short)kv[e]); } }
                sc[b * 3 + p] = valid ? dot * 0.125f : -INFINITY;
            }
        float m = sc[0];
#pragma unroll
        for (int i = 1; i < 9; ++i) m = fmaxf(m, sc[i]);
        m = wave_max(m);
        float l = 0.f;
#pragma unroll
        for (int i = 0; i < 9; ++i) { sc[i] = __expf(sc[i] - m); l += sc[i]; }
        l = wave_sum(l);
        float o = 0.f;
#pragma unroll
        for (int b = 0; b < 3; ++b)
#pragma unroll
            for (int p = 0; p < 3; ++p) {
                const int pbits = __float_as_int(sc[b * 3 + p]);
                for (int j = 0; j < 64; ++j) { const int diff = 64 * p + j, kt = t - (diff << (2 * b));
                    if (diff <= 128 && kt >= 0) { const float pj = __int_as_float(__builtin_amdgcn_readlane(pbits, j)); o += pj * bf2f(V[(size_t)kt * AW + h * 64 + lane]); } }
            }
        o = o / l;
        MIXED[(size_t)t * DM + h * 64 + lane] = (bf16)f2bf(o);
        const float q = wave_sum(o * o); if (lane == 0) atomicAdd(ss_a + t, q);
        asm volatile("" ::: "memory");
    }
}

__device__ __forceinline__ void sgu_naive(LAS unsigned char* lds, const bf16* U, const bf16* GV, const float* ln_s1, const float* ln_s2, const float* ln_g, const float* ln_b, const float* w_s, const float* b_s,
                                          bf16* MIXED, float* ss_s, int bx, int G, int tid, int lane) {
    LAS float* GT = (LAS float*)lds;
    LAS float* WL = (LAS float*)(lds + 65536);
    for (int unit = bx; unit < 64 * 8; unit += G) {
        const int c = unit >> 3, g = unit & 7;
        for (int idx = tid; idx < 128 * 128; idx += NWAVES * 64) {
            const int j = idx >> 7, d = idx & 127, tok = c * 128 + j, ch = g * 128 + d;
            const float mean = ln_s1[tok] * (1.0f / AW), var = ln_s2[tok] * (1.0f / AW) - mean * mean, rstd = 1.0f / sqrtf(var + 1e-6f);
            GT[idx] = (bf2f(GV[(size_t)tok * AW + ch]) - mean) * rstd * ln_g[ch] + ln_b[ch];
            WL[idx] = (d <= j) ? w_s[(size_t)g * 16384 + idx] : 0.f;
        }
        __syncthreads();
        const int d = tid & 127, iq = tid >> 7;
        for (int ii = 0; ii < 32; ++ii) {
            const int i = iq * 32 + ii; float acc = 0.f;
            for (int j = 0; j <= i; ++j) acc += WL[i * 128 + j] * GT[j * 128 + d];
            const int tok = c * 128 + i; const float sv = acc + b_s[g * 128 + i];
            const float o = bf2f(U[(size_t)tok * AW + g * 128 + d]) * sv;
            MIXED[(size_t)tok * DM + AW + g * 128 + d] = (bf16)f2bf(o);
            const float q = wave_sum(o * o); if (lane == 0) atomicAdd(ss_s + tok, q);
        }
        __syncthreads();
    }
}

__device__ __forceinline__ void xattn_naive(LAS unsigned char* lds, const bf16* QM, const bf16* KVM, bf16* OM, int gw, int NGW, int wave, int lane) {
    LAS float* qs = (LAS float*)lds + wave * 512;
    for (int wu = gw; wu < S_ * 4; wu += NGW) {
        const int t = wu >> 2, h = wu & 3;
        { const bf16x8 qv = *(const bf16x8*)(QM + (size_t)t * DM + h * 512 + lane * 8);
#pragma unroll
          for (int e = 0; e < 8; ++e) qs[lane * 8 + e] = bf2f((unsigned short)qv[e]); }
        LDS_WAIT(); asm volatile("" ::: "memory");
        float sc[4];
#pragma unroll
        for (int p = 0; p < 4; ++p) {
            const bf16x8* kr = (const bf16x8*)(KVM + (size_t)(64 * p + lane) * (2 * DM) + h * 512); float dot = 0.f;
            for (int c = 0; c < 64; ++c) { const bf16x8 kv = kr[c];
#pragma unroll
                for (int e = 0; e < 8; ++e) dot += qs[8 * c + e] * bf2f((unsigned short)kv[e]); }
            sc[p] = dot * 0.044194173824159216f;
        }
        float m = wave_max(fmaxf(fmaxf(sc[0], sc[1]), fmaxf(sc[2], sc[3])));
        float l = 0.f;
#pragma unroll
        for (int p = 0; p < 4; ++p) { sc[p] = __expf(sc[p] - m); l += sc[p]; }
        l = wave_sum(l);
        float o[8];
#pragma unroll
        for (int e = 0; e < 8; ++e) o[e] = 0.f;
#pragma unroll
        for (int p = 0; p < 4; ++p) { const int pbits = __float_as_int(sc[p]);
            for (int j = 0; j < 64; ++j) { const float pj = __int_as_float(__builtin_amdgcn_readlane(pbits, j));
                const bf16x8 vv = *(const bf16x8*)(KVM + (size_t)(64 * p + j) * (2 * DM) + DM + h * 512 + lane * 8);
#pragma unroll
                for (int e = 0; e < 8; ++e) o[e] += pj * bf2f((unsigned short)vv[e]); } }
        const float il = 1.0f / l;
        v4u w; w.x = pk2(o[0] * il, o[1] * il); w.y = pk2(o[2] * il, o[3] * il); w.z = pk2(o[4] * il, o[5] * il); w.w = pk2(o[6] * il, o[7] * il);
        *(v4u*)(OM + (size_t)t * DM + h * 512 + lane * 8) = w;
        asm volatile("" ::: "memory");
    }
}

typedef short v4s __attribute__((ext_vector_type(4)));
__device__ __forceinline__ v4s tr_read8(LAS unsigned char* p) { return __builtin_amdgcn_ds_read_tr16_b64_v4i16((LAS v4s*)p); }
__device__ __forceinline__ bf16x8 join8(v4s lo, v4s hi) { return (bf16x8){lo[0], lo[1], lo[2], lo[3], hi[0], hi[1], hi[2], hi[3]}; }
__device__ __forceinline__ unsigned cvtpk(float lo, float hi) { unsigned r; asm volatile("v_cvt_pk_bf16_f32 %0, %1, %2" : "=v"(r) : "v"(lo), "v"(hi)); return r; }
__device__ __forceinline__ bf16x8 packP(const f32x4 a, const f32x4 b) { v4u w; w.x = cvtpk(a[0], a[1]); w.y = cvtpk(a[2], a[3]); w.z = cvtpk(b[0], b[1]); w.w = cvtpk(b[2], b[3]); return __builtin_bit_cast(bf16x8, w); }
#define MFMA16(a, b, c) __builtin_amdgcn_mfma_f32_16x16x32_bf16((a), (b), (c), 0, 0, 0)
constexpr int KV_PB = 144, KV_TILE = 256 * KV_PB;

__device__ __forceinline__ void dattn_mfma(LAS unsigned char* lds, const bf16* Q, const bf16* K, const bf16* V, bf16* OB, float* LSE, int bx, int G, int tid, int wave, int lane) {
    asm volatile("" : "+v"(tid), "+v"(lane), "+s"(wave), "+s"(bx));
    const int g = lane >> 4, i16 = lane & 15, q4 = i16 >> 2, p4 = lane & 3;
    LAS unsigned char* Ks = lds; LAS unsigned char* Vs = lds + KV_TILE;
    constexpr int NU = 3 * 16 * 64;
    v4u kreg[4], vreg[4];
#define DA_DECODE(u, b, h, r, n, dsh) const int b = (u) >> 10, h = (u) & 15, dsh = 2 * b, r = (((u) & 1023) >> 4) & ((1 << dsh) - 1), n = (((u) & 1023) >> 4) >> dsh
#define DA_GLOAD(u) do { DA_DECODE(u, b_, h_, r_, n_, dsh_); (void)b_; _Pragma("unroll") for (int i = 0; i < 4; ++i) { const int id = tid + 512 * i, row = id >> 3, ch = id & 7, s = 128 * (n_ - 1) + row; \
        if (s >= 0) { const size_t off = ((size_t)r_ + ((size_t)s << dsh_)) * AW + h_ * 64 + ch * 8; kreg[i] = *(const v4u*)(K + off); vreg[i] = *(const v4u*)(V + off); } \
        else { kreg[i] = (v4u){0u, 0u, 0u, 0u}; vreg[i] = (v4u){0u, 0u, 0u, 0u}; } } } while (0)
    int u = bx;
    if (u < NU) DA_GLOAD(u);
    for (; u < NU; u += G) {
#pragma unroll
        for (int i = 0; i < 4; ++i) { const int id = tid + 512 * i, row = id >> 3, ch = id & 7; *(LAS v4u*)(Ks + row * KV_PB + ch * 16) = kreg[i]; *(LAS v4u*)(Vs + row * KV_PB + ch * 16) = vreg[i]; }
        __syncthreads();
        if (u + G < NU) DA_GLOAD(u + G);
        DA_DECODE(u, b, h, r, n, dsh);
        const int qi = 16 * wave + i16;
        const size_t qtok = (size_t)r + ((size_t)(128 * n + qi) << dsh);
        const bf16x8 qf0 = *(const bf16x8*)(Q + qtok * AW + h * 64 + 8 * g), qf1 = *(const bf16x8*)(Q + qtok * AW + h * 64 + 32 + 8 * g);
        f32x4 s[9];
#pragma unroll
        for (int t = 0; t < 9; ++t) { LAS unsigned char* kp = Ks + (16 * (wave + t) + i16) * KV_PB + g * 16;
            const bf16x8 k0 = *(LAS bf16x8*)kp, k1 = *(LAS bf16x8*)(kp + 64);
            s[t] = MFMA16(k0, qf0, ((f32x4){0.f, 0.f, 0.f, 0.f})); s[t] = MFMA16(k1, qf1, s[t]); }
        float mx = -INFINITY;
#pragma unroll
        for (int t = 0; t < 9; ++t)
#pragma unroll
            for (int e = 0; e < 4; ++e) { const int kj = 16 * (wave + t) + 4 * g + e, diff = qi + 128 - kj; const bool valid = (diff >= 0) && (diff <= 128) && (n > 0 || kj >= 128);
                const float v = valid ? s[t][e] * (0.125f * 1.4426950408889634f) : -INFINITY; s[t][e] = v; mx = fmaxf(mx, v); }
        mx = fmaxf(mx, __shfl_xor(mx, 16)); mx = fmaxf(mx, __shfl_xor(mx, 32));
        float l = 0.f;
#pragma unroll
        for (int t = 0; t < 9; ++t)
#pragma unroll
            for (int e = 0; e < 4; ++e) { const float p = __builtin_amdgcn_exp2f(s[t][e] - mx); s[t][e] = p; l += p; }
        l += __shfl_xor(l, 16); l += __shfl_xor(l, 32);
        f32x4 o[4];
#pragma unroll
        for (int dt = 0; dt < 4; ++dt) o[dt] = (f32x4){0.f, 0.f, 0.f, 0.f};
#pragma unroll
        for (int c = 0; c < 5; ++c) {
            const bf16x8 pf = packP(s[2 * c], (2 * c + 1 < 9) ? s[(2 * c + 1 < 9) ? 2 * c + 1 : 8] : (f32x4){0.f, 0.f, 0.f, 0.f});
            const int ktB = (wave + 2 * c + 1 < 16) ? wave + 2 * c + 1 : 15;
            LAS unsigned char* va = Vs + (16 * (wave + 2 * c) + 4 * g + q4) * KV_PB + p4 * 8; LAS unsigned char* vb = Vs + (16 * ktB + 4 * g + q4) * KV_PB + p4 * 8;
#pragma unroll
            for (int dt = 0; dt < 4; ++dt) { const v4s lo = tr_read8(va + dt * 32), hi = tr_read8(vb + dt * 32); o[dt] = MFMA16(join8(lo, hi), pf, o[dt]); }
        }
        const float il = 1.0f / l;
        bf16* op = OB + ((size_t)b * S_ + qtok) * AW + h * 64 + 4 * g;
#pragma unroll
        for (int dt = 0; dt < 4; ++dt) { v2u w; w.x = cvtpk(o[dt][0] * il, o[dt][1] * il); w.y = cvtpk(o[dt][2] * il, o[dt][3] * il); *(v2u*)(op + 16 * dt) = w; }
        if (g == 0) LSE[((size_t)b * S_ + qtok) * 16 + h] = mx + __builtin_amdgcn_logf(l);
        __syncthreads();
    }
#undef DA_DECODE
#undef DA_GLOAD
}

__device__ __forceinline__ void sgu_mfma(LAS unsigned char* lds, const bf16* U, const bf16* GV, const float* ln_s1, const float* ln_s2, const float* ln_g, const float* ln_b, const float* w_s, const float* b_s,
                                         bf16* MIXED, float* ss_s, int bx, int G, int tid, int wave, int lane) {
    asm volatile("" : "+v"(tid), "+v"(lane), "+s"(wave), "+s"(bx));
    const int g = lane >> 4, i16 = lane & 15, q4 = i16 >> 2, p4 = lane & 3;
    constexpr int PB = 272;
    LAS unsigned char* GN = lds; LAS unsigned char* WS = lds + 128 * PB;
    for (int unit = bx; unit < 64 * 8; unit += G) {
        const int c = unit >> 3, grp = unit & 7;
#pragma unroll
        for (int k = 0; k < 4; ++k) { const int id = tid + 512 * k, j = id >> 4, ch = id & 15, tok = c * 128 + j;
            const bf16x8 gv = *(const bf16x8*)(GV + (size_t)tok * AW + grp * 128 + 8 * ch);
            const float mean = ln_s1[tok] * (1.0f / AW), var = ln_s2[tok] * (1.0f / AW) - mean * mean, rstd = 1.0f / sqrtf(var + 1e-6f);
            const f32x4 lg0 = *(const f32x4*)(ln_g + grp * 128 + 8 * ch), lg1 = *(const f32x4*)(ln_g + grp * 128 + 8 * ch + 4), lb0 = *(const f32x4*)(ln_b + grp * 128 + 8 * ch), lb1 = *(const f32x4*)(ln_b + grp * 128 + 8 * ch + 4);
            f32x4 x0, x1;
#pragma unroll
            for (int e = 0; e < 4; ++e) { x0[e] = (bf2f((unsigned short)gv[e]) - mean) * rstd * lg0[e] + lb0[e]; x1[e] = (bf2f((unsigned short)gv[4 + e]) - mean) * rstd * lg1[e] + lb1[e]; }
            *(LAS bf16x8*)(GN + j * PB + ch * 16) = packP(x0, x1);
            f32x4 w0 = *(const f32x4*)(w_s + (size_t)grp * 16384 + j * 128 + 8 * ch), w1 = *(const f32x4*)(w_s + (size_t)grp * 16384 + j * 128 + 8 * ch + 4);
#pragma unroll
            for (int e = 0; e < 4; ++e) { if (8 * ch + e > j) w0[e] = 0.f; if (8 * ch + 4 + e > j) w1[e] = 0.f; }
            *(LAS bf16x8*)(WS + j * PB + ch * 16) = packP(w0, w1); }
        __syncthreads();
        f32x4 acc[8];
#pragma unroll
        for (int it = 0; it < 8; ++it) acc[it] = (f32x4){0.f, 0.f, 0.f, 0.f};
#pragma unroll
        for (int ks = 0; ks < 4; ++ks) {
            const v4s lo = tr_read8(GN + (32 * ks + 8 * g + q4) * PB + (16 * wave + 4 * p4) * 2), hi = tr_read8(GN + (32 * ks + 8 * g + 4 + q4) * PB + (16 * wave + 4 * p4) * 2);
            const bf16x8 gf = join8(lo, hi);
#pragma unroll
            for (int it = 0; it < 8; ++it) if (it >= 2 * ks) { const bf16x8 wf = *(LAS bf16x8*)(WS + (16 * it + i16) * PB + (32 * ks + 8 * g) * 2); acc[it] = MFMA16(gf, wf, acc[it]); }
        }
#pragma unroll
        for (int it = 0; it < 8; ++it) { const int i = 16 * it + i16, tok = c * 128 + i, chn = grp * 128 + 16 * wave + 4 * g; const float bias = b_s[grp * 128 + i];
            const v2u uu = *(const v2u*)(U + (size_t)tok * AW + chn);
            const float o0 = bf2f((unsigned short)(uu.x & 0xffff)) * (acc[it][0] + bias), o1 = bf2f((unsigned short)(uu.x >> 16)) * (acc[it][1] + bias);
            const float o2 = bf2f((unsigned short)(uu.y & 0xffff)) * (acc[it][2] + bias), o3 = bf2f((unsigned short)(uu.y >> 16)) * (acc[it][3] + bias);
            v2u w; w.x = cvtpk(o0, o1); w.y = cvtpk(o2, o3); *(v2u*)(MIXED + (size_t)tok * DM + AW + chn) = w;
            float q = (o0 * o0 + o1 * o1) + (o2 * o2 + o3 * o3); q += __shfl_xor(q, 16); q += __shfl_xor(q, 32);
            if (g == 0) atomicAdd(ss_s + tok, q); }
        __syncthreads();
    }
}

__device__ __forceinline__ void xattn_mfma(LAS unsigned char* lds, const bf16* QM, const bf16* KVM, bf16* OM, int bx, int G, int tid, int wave, int lane) {
    asm volatile("" : "+v"(tid), "+v"(lane), "+s"(wave), "+s"(bx));
    const int g = lane >> 4, i16 = lane & 15, q4 = i16 >> 2, p4 = lane & 3;
    v4u reg[4];
#define XA_GLOAD(c) do { _Pragma("unroll") for (int i = 0; i < 4; ++i) { const int id = tid + 512 * i, row = id >> 3, ch = id & 7; \
        reg[i] = *(const v4u*)(KVM + (size_t)row * (2 * DM) + (((c) >> 3) ? DM : 0) + h * 512 + 64 * ((c) & 7) + ch * 8); } } while (0)
#define XA_WRITE(buf) do { _Pragma("unroll") for (int i = 0; i < 4; ++i) { const int id = tid + 512 * i, row = id >> 3, ch = id & 7; *(LAS v4u*)((buf) + row * KV_PB + ch * 16) = reg[i]; } } while (0)
    for (int unit = bx; unit < 256; unit += G) {
        const int h = unit & 3, qt = unit >> 2;
        const size_t tokq = (size_t)128 * qt + 16 * wave + i16;
        XA_GLOAD(0); XA_WRITE(lds); __syncthreads();
        f32x4 s[16];
#pragma unroll
        for (int kt = 0; kt < 16; ++kt) s[kt] = (f32x4){0.f, 0.f, 0.f, 0.f};
        for (int c = 0; c < 8; ++c) {
            XA_GLOAD(c + 1);
            LAS unsigned char* buf = lds + (c & 1) * KV_TILE;
            const bf16x8 qf0 = *(const bf16x8*)(QM + tokq * DM + h * 512 + 64 * c + 8 * g), qf1 = *(const bf16x8*)(QM + tokq * DM + h * 512 + 64 * c + 32 + 8 * g);
#pragma unroll
            for (int kt = 0; kt < 16; ++kt) { LAS unsigned char* kp = buf + (16 * kt + i16) * KV_PB + g * 16;
                const bf16x8 k0 = *(LAS bf16x8*)kp, k1 = *(LAS bf16x8*)(kp + 64); s[kt] = MFMA16(k0, qf0, s[kt]); s[kt] = MFMA16(k1, qf1, s[kt]); }
            XA_WRITE(lds + ((c + 1) & 1) * KV_TILE);
            __syncthreads();
        }
        float mx = -INFINITY;
#pragma unroll
        for (int kt = 0; kt < 16; ++kt)
#pragma unroll
            for (int e = 0; e < 4; ++e) { s[kt][e] *= (0.044194173824159216f * 1.4426950408889634f); mx = fmaxf(mx, s[kt][e]); }
        mx = fmaxf(mx, __shfl_xor(mx, 16)); mx = fmaxf(mx, __shfl_xor(mx, 32));
        float l = 0.f;
#pragma unroll
        for (int kt = 0; kt < 16; ++kt)
#pragma unroll
            for (int e = 0; e < 4; ++e) { const float p = __builtin_amdgcn_exp2f(s[kt][e] - mx); s[kt][e] = p; l += p; }
        l += __shfl_xor(l, 16); l += __shfl_xor(l, 32);
        const float il = 1.0f / l;
        bf16x8 pf[8];
#pragma unroll
        for (int kc = 0; kc < 8; ++kc) pf[kc] = packP(s[2 * kc], s[2 * kc + 1]);
        for (int c = 8; c < 16; ++c) {
            if (c + 1 < 16) XA_GLOAD(c + 1);
            LAS unsigned char* buf = lds + (c & 1) * KV_TILE;
            f32x4 o[4];
#pragma unroll
            for (int dt = 0; dt < 4; ++dt) o[dt] = (f32x4){0.f, 0.f, 0.f, 0.f};
#pragma unroll
            for (int kc = 0; kc < 8; ++kc) { LAS unsigned char* va = buf + (32 * kc + 4 * g + q4) * KV_PB + p4 * 8; LAS unsigned char* vb = va + 16 * KV_PB;
#pragma unroll
                for (int dt = 0; dt < 4; ++dt) { const v4s lo = tr_read8(va + dt * 32), hi = tr_read8(vb + dt * 32); o[dt] = MFMA16(join8(lo, hi), pf[kc], o[dt]); } }
            bf16* op = OM + tokq * DM + h * 512 + 64 * (c - 8) + 4 * g;
#pragma unroll
            for (int dt = 0; dt < 4; ++dt) { v2u w; w.x = cvtpk(o[dt][0] * il, o[dt][1] * il); w.y = cvtpk(o[dt][2] * il, o[dt][3] * il); *(v2u*)(op + 16 * dt) = w; }
            if (c + 1 < 16) XA_WRITE(lds + ((c + 1) & 1) * KV_TILE);
            __syncthreads();
        }
    }
#undef XA_GLOAD
#undef XA_WRITE
}

__global__ void __launch_bounds__(NWAVES * 64, 2) mega_fwd(Args args) {
    extern __shared__ __attribute__((aligned(16))) unsigned char lds_raw[];
    LAS unsigned char* lds = (LAS unsigned char*)lds_raw;
    cg::grid_group grid = cg::this_grid();
    const int tid = threadIdx.x, lane = tid & 63, wave = __builtin_amdgcn_readfirstlane(tid >> 6);
    const int G = gridDim.x, bx = blockIdx.x;
    unsigned char* ws = args.ws;
    float* SS = (float*)(ws + WS_CTL);
    float* cosT = (float*)(ws + WS_COS); float* sinT = (float*)(ws + WS_SIN);
    bf16* MK = (bf16*)(ws + WS_MK); bf16* KVM = (bf16*)(ws + WS_KVM);
    bf16* WGU1 = (bf16*)(ws + WS_WGU1); bf16* WD1 = (bf16*)(ws + WS_WD1); bf16* WGU2 = (bf16*)(ws + WS_WGU2); bf16* WD2 = (bf16*)(ws + WS_WD2);
    bf16* WIN = (bf16*)(ws + WS_WIN); bf16* WOUT = (bf16*)(ws + WS_WOUT); bf16* WQ = (bf16*)(ws + WS_WQ); bf16* WKV = (bf16*)(ws + WS_WKV); bf16* WO = (bf16*)(ws + WS_WO);
    bf16* XN = (bf16*)(ws + WS_XN); bf16* MIXED = (bf16*)(ws + WS_MIXED); bf16* HB = (bf16*)(ws + WS_ACT);
    bf16* Qb = (bf16*)(ws + WS_Q); bf16* Kb = (bf16*)(ws + WS_K); bf16* Vb = (bf16*)(ws + WS_V); bf16* Ub = (bf16*)(ws + WS_U); bf16* GVb = (bf16*)(ws + WS_GV);
    bf16* OBb = (bf16*)(ws + WS_OB); float* LSEb = (float*)(ws + WS_LSE);
    bf16* QM = (bf16*)(ws + WS_QM); bf16* OM = (bf16*)(ws + WS_OM);
    const float* x = (const float*)args.in[0]; const float* mem = (const float*)args.in[1]; const int* positions = (const int*)args.in[2];
    float* HRES = args.out;
    const int lo = args.ph_lo, hi = args.ph_hi;
#ifndef PMASK
#define PMASK 0xFFFF
#endif
#define IN(k) (lo <= (k) && (k) < hi && ((PMASK >> (k)) & 1))
#ifdef PROBE_LO
#define STAMP(k) do { if (bx == 0 && tid == 0) ((unsigned long long*)(ws + WS_CTL + 512 * 1024))[(k) + 1] = __builtin_amdgcn_s_memrealtime(); } while (0)
#else
#define STAMP(k) do { } while (0)
#endif
#define SEAM(k) do { if (IN(k) && IN((k) + 1)) grid.sync(); STAMP(k); } while (0)
    const int gw = bx * NWAVES + wave, NGW = G * NWAVES;
    const int gt = bx * (NWAVES * 64) + tid, NGT = G * NWAVES * 64;

    STAMP(-1);
    if (IN(0)) {
        LAS float* scr = (LAS float*)(lds + wave * 17408);
#define INF(k) ((const float*)args.in[k])
        constexpr int I_GU = (DM / 64) * (DFF / 64), I_D = (DFF / 64) * (DM / 64), I_IN = (DM / 64) * (DIN / 64), I_SQ = (DM / 64) * (DM / 64);
        constexpr int NITEMS = 2 * (2 * I_GU + I_D) + I_IN + 5 * I_SQ;
        for (int it = gw; it < NITEMS; it += NGW) {
            int r = it;
            if (r < I_GU) { tr_job(INF(4), DM, DFF, INF(3), nullptr, WGU1, 0, 1, r, scr, lane); continue; } r -= I_GU;
            if (r < I_GU) { tr_job(INF(5), DM, DFF, INF(3), nullptr, WGU1, 0, 2, r, scr, lane); continue; } r -= I_GU;
            if (r < I_D) { tr_job(INF(6), DFF, DM, nullptr, nullptr, WD1, 0, 0, r, scr, lane); continue; } r -= I_D;
            if (r < I_GU) { tr_job(INF(23), DM, DFF, INF(22), nullptr, WGU2, 0, 1, r, scr, lane); continue; } r -= I_GU;
            if (r < I_GU) { tr_job(INF(24), DM, DFF, INF(22), nullptr, WGU2, 0, 2, r, scr, lane); continue; } r -= I_GU;
            if (r < I_D) { tr_job(INF(25), DFF, DM, nullptr, nullptr, WD2, 0, 0, r, scr, lane); continue; } r -= I_D;
            if (r < I_IN) { tr_job(INF(8), DM, DIN, INF(7), nullptr, WIN, 0, 3, r, scr, lane); continue; } r -= I_IN;
            if (r < I_SQ) { tr_job(INF(15), DM, DM, INF(13), INF(14), WOUT, 0, 0, r, scr, lane); continue; } r -= I_SQ;
            if (r < I_SQ) { tr_job(INF(18), DM, DM, INF(16), nullptr, WQ, 0, 0, r, scr, lane); continue; } r -= I_SQ;
            if (r < I_SQ) { tr_job(INF(19), DM, DM, nullptr, nullptr, WKV, 0, 0, r, scr, lane); continue; } r -= I_SQ;
            if (r < I_SQ) { tr_job(INF(20), DM, DM, nullptr, nullptr, WKV, 2048, 0, r, scr, lane); continue; } r -= I_SQ;
            tr_job(INF(21), DM, DM, nullptr, nullptr, WO, 0, 0, r, scr, lane);
        }
        for (int m = gw; m < S_; m += NGW) {
            const f32x4* xr = (const f32x4*)(x + (size_t)m * DM) + lane; float s = 0.f; v2u* o8 = (v2u*)(XN + (size_t)m * DM) + lane;
#pragma unroll
            for (int j = 0; j < 8; ++j) { const f32x4 v = xr[64 * j]; s += (v[0] * v[0] + v[1] * v[1]) + (v[2] * v[2] + v[3] * v[3]); v2u w; w.x = pk2(v[0], v[1]); w.y = pk2(v[2], v[3]); o8[64 * j] = w; }
            s = wave_sum(s); if (lane == 0) SS[SS_X * S_ + m] = s;
        }
        for (int m = gw; m < NMEM; m += NGW) {
            const f32x4* xr = (const f32x4*)(mem + (size_t)m * DM) + lane; const f32x4* gr = (const f32x4*)(INF(17)) + lane; float s = 0.f; f32x4 v[8];
#pragma unroll
            for (int j = 0; j < 8; ++j) { v[j] = xr[64 * j]; s += (v[j][0] * v[j][0] + v[j][1] * v[j][1]) + (v[j][2] * v[j][2] + v[j][3] * v[j][3]); }
            const float rs = 1.0f / sqrtf(wave_sum(s) * (1.0f / DM) + 1e-6f); v2u* o8 = (v2u*)(MK + (size_t)m * DM) + lane;
#pragma unroll
            for (int j = 0; j < 8; ++j) { const f32x4 g = gr[64 * j]; v2u w; w.x = pk2(v[j][0] * rs * g[0], v[j][1] * rs * g[1]); w.y = pk2(v[j][2] * rs * g[2], v[j][3] * rs * g[3]); o8[64 * j] = w; }
        }
        for (int i = gt; i < (SS_N - 1) * S_; i += NGT) SS[S_ + i] = 0.f;
        for (int i = gt; i < S_ * 32; i += NGT) {
            const int row = i >> 5, dd = i & 31; const double xx = (double)positions[row] * INVF[dd];
            const double kq = __builtin_rint(xx * 0.6366197723675814);
            double rr = __builtin_fma(-kq, 1.5707963267948966, xx); rr = __builtin_fma(-kq, 6.123233995736766e-17, rr);
            const int q = ((int)kq) & 3; const double r2 = rr * rr;
            double sn = -1.0 / 1307674368000.0; sn = sn * r2 + 1.0 / 6227020800.0; sn = sn * r2 - 1.0 / 39916800.0; sn = sn * r2 + 1.0 / 362880.0; sn = sn * r2 - 1.0 / 5040.0; sn = sn * r2 + 1.0 / 120.0; sn = sn * r2 - 1.0 / 6.0; sn = sn * r2 + 1.0; sn *= rr;
            double cs = 1.0 / 20922789888000.0; cs = cs * r2 - 1.0 / 87178291200.0; cs = cs * r2 + 1.0 / 479001600.0; cs = cs * r2 - 1.0 / 3628800.0; cs = cs * r2 + 1.0 / 40320.0; cs = cs * r2 - 1.0 / 720.0; cs = cs * r2 + 1.0 / 24.0; cs = cs * r2 - 0.5; cs = cs * r2 + 1.0;
            const double sv = (q == 0) ? sn : (q == 1) ? cs : (q == 2) ? -sn : -cs;
            const double cv = (q == 0) ? cs : (q == 1) ? -sn : (q == 2) ? -cs : sn;
            cosT[i] = (float)cv; sinT[i] = (float)sv;
        }
    }
    SEAM(0);

    if (IN(1)) {
        pg8::Gemm g{XN, WGU1, S_, 2 * DFF, DM}; pg8::StaticOrder S; S.init(S_, 2 * DFF, G, bx);
        pg8::EpiSwiglu E{HB, DFF, SS + SS_X * S_, 1.0f / DM};
        pg8::gemm_phase<pg8::EpiSwiglu, pg8::StaticOrder, true, true>(lds, g, S, E);
    }
    SEAM(1);
    if (IN(2)) {
        pg8::Gemm g{HB, WD1, S_, DM, DFF}; pg8::StaticOrder S; S.init(S_, DM, G, bx);
        pg8::EpiResid<false> E{x, HRES, XN, SS + SS_H1 * S_, nullptr, 0.f, 0.5f, nullptr};
        pg8::gemm_phase<pg8::EpiResid<false>, pg8::StaticOrder, true, true>(lds, g, S, E);
    }
    SEAM(2);
    if (IN(3)) {
        { pg8::Gemm g{XN, WIN, S_, DIN, DM}; pg8::StaticOrder S; S.init(S_, DIN, G, bx);
          pg8::EpiWin E{Qb, (size_t)(8u << 20), SS + SS_H1 * S_, 1.0f / DM, cosT, sinT, SS + LN_S1 * S_, SS + LN_S2 * S_};
          pg8::gemm_phase<pg8::EpiWin, pg8::StaticOrder, true, true>(lds, g, S, E); }
        { pg8::Gemm g{MK, WKV, NMEM, 2 * DM, DM}; pg8::StaticOrder S; S.init(NMEM, 2 * DM, G, (bx + G / 2) % G);
          pg8::EpiBf16Scale E{KVM, 2 * DM, nullptr, 0.f};
          pg8::gemm_phase<pg8::EpiBf16Scale, pg8::StaticOrder, true, true>(lds, g, S, E); }
    }
    SEAM(3);
    if (IN(4)) {
#if USE_MFMA_ATTN
        dattn_mfma(lds, Qb, Kb, Vb, OBb, LSEb, bx, G, tid, wave, lane);
#else
        attn_naive(lds, Qb, Kb, Vb, MIXED, SS + SS_A * S_, gw, NGW, wave, lane);
        __syncthreads();
#endif
#if USE_MFMA_SGU
        sgu_mfma(lds, Ub, GVb, SS + LN_S1 * S_, SS + LN_S2 * S_, (const float*)args.in[9], (const float*)args.in[10], (const float*)args.in[11], (const float*)args.in[12], MIXED, SS + SS_S * S_, bx, G, tid, wave, lane);
#else
        sgu_naive(lds, Ub, GVb, SS + LN_S1 * S_, SS + LN_S2 * S_, (const float*)args.in[9], (const float*)args.in[10], (const float*)args.in[11], (const float*)args.in[12], MIXED, SS + SS_S * S_, bx, G, tid, lane);
#endif
    }
    SEAM(4);
    if (IN(5)) {
        for (int m = gw; m < S_; m += NGW) {
            const float rsg = 1.0f / sqrtf(SS[SS_S * S_ + m] * (1.0f / AW) + 1e-6f);
            v4u* p = (v4u*)(MIXED + (size_t)m * DM) + lane;
#if USE_MFMA_ATTN
            float val[2][8]; float ssq = 0.f;
#pragma unroll
            for (int j = 0; j < 2; ++j) { const int c = lane + 64 * j, hh = c >> 3;
                const float l0 = LSEb[((size_t)0 * S_ + m) * 16 + hh], l1 = LSEb[((size_t)1 * S_ + m) * 16 + hh], l2 = LSEb[((size_t)2 * S_ + m) * 16 + hh];
                const float mx = fmaxf(l0, fmaxf(l1, l2)); float w0 = __builtin_amdgcn_exp2f(l0 - mx), w1 = __builtin_amdgcn_exp2f(l1 - mx), w2 = __builtin_amdgcn_exp2f(l2 - mx);
                const float inv = 1.0f / (w0 + w1 + w2); w0 *= inv; w1 *= inv; w2 *= inv;
                const bf16x8 a0 = *(const bf16x8*)(OBb + ((size_t)0 * S_ + m) * AW + 8 * c), a1 = *(const bf16x8*)(OBb + ((size_t)1 * S_ + m) * AW + 8 * c), a2 = *(const bf16x8*)(OBb + ((size_t)2 * S_ + m) * AW + 8 * c);
#pragma unroll
                for (int e = 0; e < 8; ++e) { const float v = w0 * bf2f((unsigned short)a0[e]) + w1 * bf2f((unsigned short)a1[e]) + w2 * bf2f((unsigned short)a2[e]); val[j][e] = v; ssq += v * v; } }
            const float ra = 1.0f / sqrtf(wave_sum(ssq) * (1.0f / AW) + 1e-6f);
#pragma unroll
            for (int j = 0; j < 2; ++j) { v4u w; w.x = pk2(val[j][0] * ra, val[j][1] * ra); w.y = pk2(val[j][2] * ra, val[j][3] * ra); w.z = pk2(val[j][4] * ra, val[j][5] * ra); w.w = pk2(val[j][6] * ra, val[j][7] * ra); p[64 * j] = w; }
#else
            const float ra = 1.0f / sqrtf(SS[SS_A * S_ + m] * (1.0f / AW) + 1e-6f);
#endif
#pragma unroll
            for (int j = (USE_MFMA_ATTN ? 2 : 0); j < 4; ++j) { v4u w = p[64 * j]; const float sc = j < 2 ? ra : rsg;
                w.x = pk2(bf2f((unsigned short)(w.x & 0xffff)) * sc, bf2f((unsigned short)(w.x >> 16)) * sc); w.y = pk2(bf2f((unsigned short)(w.y & 0xffff)) * sc, bf2f((unsigned short)(w.y >> 16)) * sc);
                w.z = pk2(bf2f((unsigned short)(w.z & 0xffff)) * sc, bf2f((unsigned short)(w.z >> 16)) * sc); w.w = pk2(bf2f((unsigned short)(w.w & 0xffff)) * sc, bf2f((unsigned short)(w.w >> 16)) * sc);
                p[64 * j] = w; }
        }
    }
    SEAM(5);
    if (IN(6)) {
        pg8::Gemm g{MIXED, WOUT, S_, DM, DM}; pg8::StaticOrder S; S.init(S_, DM, G, bx);
        pg8::EpiResid<false> E{HRES, HRES, XN, SS + SS_H2 * S_, nullptr, 0.f, 1.0f, nullptr};
        pg8::gemm_phase<pg8::EpiResid<false>, pg8::StaticOrder, true, true>(lds, g, S, E);
    }
    SEAM(6);
    if (IN(7)) {
        pg8::Gemm g{XN, WQ, S_, DM, DM}; pg8::StaticOrder S; S.init(S_, DM, G, bx);
        pg8::EpiBf16Scale E{QM, DM, SS + SS_H2 * S_, 1.0f / DM};
        pg8::gemm_phase<pg8::EpiBf16Scale, pg8::StaticOrder, true, true>(lds, g, S, E);
    }
    SEAM(7);
    if (IN(8)) {
#if USE_MFMA_XATTN
        xattn_mfma(lds, QM, KVM, OM, bx, G, tid, wave, lane);
#else
        xattn_naive(lds, QM, KVM, OM, gw, NGW, wave, lane);
#endif
    }
    SEAM(8);
    if (IN(9)) {
        pg8::Gemm g{OM, WO, S_, DM, DM}; pg8::StaticOrder S; S.init(S_, DM, G, bx);
        pg8::EpiResid<false> E{HRES, HRES, XN, SS + SS_H3 * S_, nullptr, 0.f, 1.0f, nullptr};
        pg8::gemm_phase<pg8::EpiResid<false>, pg8::StaticOrder, true, true>(lds, g, S, E);
    }
    SEAM(9);
    if (IN(10)) {
        pg8::Gemm g{XN, WGU2, S_, 2 * DFF, DM}; pg8::StaticOrder S; S.init(S_, 2 * DFF, G, bx);
        pg8::EpiSwiglu E{HB, DFF, SS + SS_H3 * S_, 1.0f / DM};
        pg8::gemm_phase<pg8::EpiSwiglu, pg8::StaticOrder, true, true>(lds, g, S, E);
    }
    SEAM(10);
    if (IN(11)) {
        pg8::Gemm g{HB, WD2, S_, DM, DFF}; pg8::StaticOrder S; S.init(S_, DM, G, bx);
        pg8::EpiResid<false> E{HRES, HRES, nullptr, SS + SS_H4 * S_, nullptr, 0.f, 0.5f, nullptr};
        pg8::gemm_phase<pg8::EpiResid<false>, pg8::StaticOrder, true, true>(lds, g, S, E);
    }
    SEAM(11);
    if (IN(12)) {
        const float* fg = (const float*)args.in[26];
        for (int m = gw; m < S_; m += NGW) {
            f32x4* xr = (f32x4*)(HRES + (size_t)m * DM) + lane; const f32x4* gr = (const f32x4*)fg + lane;
            const float rs = 1.0f / sqrtf(SS[SS_H4 * S_ + m] * (1.0f / DM) + 1e-6f);
            float pert = 0.f;
#ifdef PROBE_LO
            if (m < 8) { const unsigned long long* ts = (const unsigned long long*)(ws + WS_CTL + 512 * 1024); const float t_us = (float)(ts[PROBE_HI + 1] - ts[PROBE_LO]) * 0.01f; pert = sqrtf(t_us * 1.024e-5f); }
#endif
#pragma unroll
            for (int j = 0; j < 8; ++j) { f32x4 v = xr[64 * j]; const f32x4 g = gr[64 * j]; v = v * rs * g + pert; xr[64 * j] = v; }
        }
    }
#undef IN
#undef SEAM
}

constexpr int NPH = 13;
extern "C" void kernel_launch(void* const* d_in, const int* in_sizes, int n_in, void* d_out, int out_size, void* d_ws, size_t ws_size, hipStream_t stream) {
    static int grid = 0;
    if (grid == 0) {
        if (n_in != 27 || out_size != S_ * DM || ws_size < WS_END) { fprintf(stderr, "kernel_launch: unexpected problem (n_in %d out %d ws %zu)\n", n_in, out_size, ws_size); grid = -1; return; }
        int dev = 0, cus = 0, per_cu = 0;
        hipGetDevice(&dev); hipDeviceGetAttribute(&cus, hipDeviceAttributeMultiprocessorCount, dev);
        hipFuncSetAttribute((const void*)mega_fwd, hipFuncAttributeMaxDynamicSharedMemorySize, LDS_BYTES);
        hipOccupancyMaxActiveBlocksPerMultiprocessor(&per_cu, (const void*)mega_fwd, NWAVES * 64, LDS_BYTES);
        if (per_cu < 1) per_cu = 1;
        (void)hipGetLastError();
        grid = cus * 1;
        fprintf(stderr, "kernel_launch: cus %d per_cu %d grid %d\n", cus, per_cu, grid);
    }
    if (grid < 0) return;
    Args a{};
    for (int i = 0; i < 27; ++i) a.in[i] = d_in[i];
    a.out = (float*)d_out; a.ws = (unsigned char*)d_ws; a.ph_lo = 0; a.ph_hi = NPH;
    void* kargs[] = {&a};
    hipError_t e = hipLaunchCooperativeKernel((const void*)mega_fwd, dim3(grid), dim3(NWAVES * 64), kargs, LDS_BYTES, stream);
    if (e != hipSuccess) fprintf(stderr, "cooperative launch failed: %s (grid %d)\n", hipGetErrorString(e), grid);
}
```

```cpp
#include <hip/hip_runtime.h>
#include <hip/hip_cooperative_groups.h>
#include <cstdio>
#include <cstdint>
#include <cmath>
namespace cg = cooperative_groups;
namespace pg8 {
#define PG8_LAS __attribute__((address_space(3)))
typedef unsigned short bf16_t;
typedef short bf16x8 __attribute__((ext_vector_type(8)));
typedef float f32x4 __attribute__((ext_vector_type(4)));
typedef unsigned u32x4 __attribute__((ext_vector_type(4)));
constexpr int BM = 256, BK = 64, HALF = 128, HTB = HALF * BK * 2  , STAGE_BYTES = 8 * HTB, NXCD = 8, WGM = 8;

__host__ __device__ __forceinline__ int lds_byte(int r, int c) { const int st = (r >> 4) * 2 + (c >> 5), rr = r & 15, cc = c & 31, ob = rr * 64 + cc * 2; return st * 1024 + (ob ^ (((ob >> 9) & 1) << 5)); }
__host__ __device__ __forceinline__ void stage_rc(int b, int& R, int& C) { const int st = b / 1024, sb = b % 1024, swz = sb ^ (((sb >> 9) & 1) << 5); R = (st >> 1) * 16 + swz / 64; C = (st & 1) * 32 + (swz % 64) / 2; }
__host__ __device__ __forceinline__ int perm32(int rho) { const int n = rho >> 4, i = rho & 15; return 8 * (i >> 2) + 4 * n + (i & 3); }

struct Unit { int pm, pn; };
struct Gemm { const bf16_t* A; const bf16_t* Bt; int M, N, K; };

struct StaticOrder {
    int nM, nN, nwg, G, c;
    __host__ __device__ void init(int M, int N, int G_, int c_) { nM = M / BM; nN = N / BM; nwg = nM * nN; G = G_; c = c_; }
    __host__ __device__ bool next(int i, Unit& u) const {
        const long L = (long)i * G + c; if (L >= nwg) return false;
        int wgid = (int)L; { const int q = nwg / NXCD, r = nwg % NXCD, xcd = wgid % NXCD, off = wgid / NXCD; wgid = (xcd < r ? xcd * (q + 1) : r * (q + 1) + (xcd - r) * q) + off; }
        const int nig = WGM * nN, gid = wgid / nig, fm = gid * WGM, gsz = (nM - fm) < WGM ? (nM - fm) : WGM;
        u.pm = fm + ((wgid % nig) % gsz); u.pn = (wgid % nig) / gsz; return true;
    }
    __device__ __forceinline__ void a_ready(const Unit&) const {}
    __device__ __forceinline__ void done(const Unit&) const {}
};

__device__ __forceinline__ unsigned cvt_pk_bf16(float lo, float hi) { unsigned r; asm volatile("v_cvt_pk_bf16_f32 %0, %1, %2" : "=v"(r) : "v"(lo), "v"(hi)); return r; }
typedef float f32x2 __attribute__((ext_vector_type(2)));
constexpr float NEPS = 1e-6f;
__device__ __forceinline__ float fast_sigmoid(float z) { return __builtin_amdgcn_rcpf(1.0f + __builtin_amdgcn_exp2f(-1.4426950408889634f * z)); }
__device__ __forceinline__ float silu_f(float x) { return x * fast_sigmoid(x); }
__device__ __forceinline__ float gelu_tanh_f(float x) { const float z = 1.5957691216057308f * (x + 0.044715f * x * x * x); return x * fast_sigmoid(z); }
__device__ __forceinline__ u32x4 pack8(const f32x4 a, const f32x4 b) { u32x4 w; w.x = cvt_pk_bf16(a[0], a[1]); w.y = cvt_pk_bf16(a[2], a[3]); w.z = cvt_pk_bf16(b[0], b[1]); w.w = cvt_pk_bf16(b[2], b[3]); return w; }

struct EpiSwiglu {
    static constexpr bool PERM = true, AFTER_DRAIN = false, MID = false;
    bf16_t* H; int ldh; const float* ss; float invw;
    __device__ __forceinline__ void operator()(const f32x4 (&acc)[2][2][4][2], const Unit& u, int wr, int wc, int fr, int fq) const {
        const int row0 = u.pm * BM + wr * 64 + fr, col0 = u.pn * HALF + wc * 32 + 8 * fq;
        float rsv[2][4];
#pragma unroll
        for (int ai = 0; ai < 2; ++ai)
#pragma unroll
            for (int m = 0; m < 4; ++m) rsv[ai][m] = ss[row0 + ai * HALF + m * 16];
#pragma unroll
        for (int ai = 0; ai < 2; ++ai)
#pragma unroll
            for (int m = 0; m < 4; ++m) { const int r = row0 + ai * HALF + m * 16; const float rs = __builtin_amdgcn_rsqf(rsv[ai][m] * invw + NEPS);
                f32x4 h0, h1;
#pragma unroll
                for (int j = 0; j < 4; ++j) { h0[j] = silu_f(acc[ai][0][m][0][j] * rs) * (acc[ai][1][m][0][j] * rs); h1[j] = silu_f(acc[ai][0][m][1][j] * rs) * (acc[ai][1][m][1][j] * rs); }
                *(u32x4*)(H + (size_t)r * ldh + col0) = pack8(h0, h1); }
    }
};

template <bool HAS_MID> struct EpiResid {
    static constexpr bool PERM = true, AFTER_DRAIN = false, MID = HAS_MID;
    const float* base; float* out; bf16_t* xn; float* ss_out; const float* ss_in; float invw_in; float alpha; const float* ss_mid;
    __device__ __forceinline__ void mid(f32x4 (&acc)[2][2][4][2], const Unit& u, int wr, int fr) const {
        const int row0 = u.pm * BM + wr * 64 + fr;
#pragma unroll
        for (int ai = 0; ai < 2; ++ai)
#pragma unroll
            for (int m = 0; m < 4; ++m) { const int r = row0 + ai * HALF + m * 16;
                const float ratio = __builtin_amdgcn_rsqf(ss_mid[r] * invw_in + NEPS) * __builtin_sqrtf(ss_in[r] * invw_in + NEPS);
#pragma unroll
                for (int bj = 0; bj < 2; ++bj)
#pragma unroll
                    for (int n = 0; n < 2; ++n) acc[ai][bj][m][n] = acc[ai][bj][m][n] * ratio; }
    }
    __device__ __forceinline__ void operator()(const f32x4 (&acc)[2][2][4][2], const Unit& u, int wr, int wc, int fr, int fq) const {
        const int row0 = u.pm * BM + wr * 64 + fr, col0 = u.pn * BM + wc * 32 + 8 * fq;
        const float sc = alpha;
#pragma unroll
        for (int ai = 0; ai < 2; ++ai) {
            f32x4 bb[4][2][2];
#pragma unroll
            for (int m = 0; m < 4; ++m)
#pragma unroll
                for (int bj = 0; bj < 2; ++bj) { const size_t off = (size_t)(row0 + ai * HALF + m * 16) * 2048 + col0 + bj * HALF; bb[m][bj][0] = *(const f32x4*)(base + off); bb[m][bj][1] = *(const f32x4*)(base + off + 4); }
#pragma unroll
            for (int m = 0; m < 4; ++m) { const int r = row0 + ai * HALF + m * 16; float q = 0.f;
#pragma unroll
                for (int bj = 0; bj < 2; ++bj) { const size_t off = (size_t)r * 2048 + col0 + bj * HALF;
                    const f32x4 o0 = bb[m][bj][0] + acc[ai][bj][m][0] * sc, o1 = bb[m][bj][1] + acc[ai][bj][m][1] * sc;
                    *(f32x4*)(out + off) = o0; *(f32x4*)(out + off + 4) = o1;
                    q += (o0[0] * o0[0] + o0[1] * o0[1]) + (o0[2] * o0[2] + o0[3] * o0[3]) + (o1[0] * o1[0] + o1[1] * o1[1]) + (o1[2] * o1[2] + o1[3] * o1[3]);
                    if (xn) *(u32x4*)(xn + off) = pack8(o0, o1); }
                q += __shfl_xor(q, 16); q += __shfl_xor(q, 32);
                if (fq == 0) atomicAdd(ss_out + r, q); }
        }
    }
};

struct EpiBf16Scale {
    static constexpr bool PERM = true, AFTER_DRAIN = false, MID = false;
    bf16_t* O; int ldc; const float* ss; float invw;
    __device__ __forceinline__ void operator()(const f32x4 (&acc)[2][2][4][2], const Unit& u, int wr, int wc, int fr, int fq) const {
        const int row0 = u.pm * BM + wr * 64 + fr, col0 = u.pn * BM + wc * 32 + 8 * fq;
        float rsv[2][4];
#pragma unroll
        for (int ai = 0; ai < 2; ++ai)
#pragma unroll
            for (int m = 0; m < 4; ++m) rsv[ai][m] = ss ? ss[row0 + ai * HALF + m * 16] : 1.0f;
#pragma unroll
        for (int ai = 0; ai < 2; ++ai)
#pragma unroll
            for (int m = 0; m < 4; ++m) { const int r = row0 + ai * HALF + m * 16; const float rs = ss ? __builtin_amdgcn_rsqf(rsv[ai][m] * invw + NEPS) : 1.0f;
#pragma unroll
                for (int bj = 0; bj < 2; ++bj) *(u32x4*)(O + (size_t)r * ldc + col0 + bj * HALF) = pack8(acc[ai][bj][m][0] * rs, acc[ai][bj][m][1] * rs); }
    }
};

struct EpiWin {
    static constexpr bool PERM = true, AFTER_DRAIN = false, MID = false;
    bf16_t* QKVUG; size_t rstride; const float* ss; float invw; const float* cosT; const float* sinT; float* ln_s1; float* ln_s2;
    __device__ __forceinline__ void operator()(const f32x4 (&acc)[2][2][4][2], const Unit& u, int wr, int wc, int fr, int fq) const {
        const int reg = u.pn >> 2, cc = (u.pn & 3) * BM, row0 = u.pm * BM + wr * 64 + fr;
        float rsv[2][4];
#pragma unroll
        for (int ai = 0; ai < 2; ++ai)
#pragma unroll
            for (int m = 0; m < 4; ++m) rsv[ai][m] = ss[row0 + ai * HALF + m * 16];
        if (reg < 2) {
            bf16_t* O = QKVUG + (size_t)reg * rstride;
#pragma unroll
            for (int aim = 0; aim < 4; ++aim) { const int ai = aim >> 1;
                f32x4 cs[2][4];
#pragma unroll
                for (int mm = 0; mm < 2; ++mm) { const size_t ro = (size_t)(row0 + ai * HALF + ((aim & 1) * 2 + mm) * 16) * 32 + 8 * fq;
                    cs[mm][0] = *(const f32x4*)(cosT + ro); cs[mm][1] = *(const f32x4*)(cosT + ro + 4); cs[mm][2] = *(const f32x4*)(sinT + ro); cs[mm][3] = *(const f32x4*)(sinT + ro + 4); }
#pragma unroll
                for (int mm = 0; mm < 2; ++mm) { const int m = (aim & 1) * 2 + mm; const int r = row0 + ai * HALF + m * 16; const float rs = __builtin_amdgcn_rsqf(rsv[ai][m] * invw + NEPS);
                    const f32x4 c0 = cs[mm][0], c1 = cs[mm][1], s0 = cs[mm][2], s1 = cs[mm][3];
                    const f32x4 a0 = acc[ai][0][m][0] * rs, a1 = acc[ai][0][m][1] * rs, b0 = acc[ai][1][m][0] * rs, b1 = acc[ai][1][m][1] * rs;
                    const f32x4 lo0 = a0 * c0 - b0 * s0, lo1 = a1 * c1 - b1 * s1, hi0 = a0 * s0 + b0 * c0, hi1 = a1 * s1 + b1 * c1;
                    bf16_t* p = O + (size_t)r * 1024 + cc + 64 * wc + 8 * fq;
                    *(u32x4*)p = pack8(lo0, lo1); *(u32x4*)(p + 32) = pack8(hi0, hi1); }
            }
        } else {
            bf16_t* O = QKVUG + (size_t)reg * rstride;
#pragma unroll
            for (int ai = 0; ai < 2; ++ai)
#pragma unroll
                for (int m = 0; m < 4; ++m) { const int r = row0 + ai * HALF + m * 16; const float rs = __builtin_amdgcn_rsqf(rsv[ai][m] * invw + NEPS);
                    float s1 = 0.f, s2 = 0.f;
#pragma unroll
                    for (int bj = 0; bj < 2; ++bj) { f32x4 v0 = acc[ai][bj][m][0] * rs, v1 = acc[ai][bj][m][1] * rs;
                        if (reg >= 3) {
#pragma unroll
                            for (int j = 0; j < 4; ++j) { v0[j] = gelu_tanh_f(v0[j]); v1[j] = gelu_tanh_f(v1[j]); } }
                        if (reg == 4) { s1 += (v0[0] + v0[1]) + (v0[2] + v0[3]) + (v1[0] + v1[1]) + (v1[2] + v1[3]);
                            s2 += (v0[0] * v0[0] + v0[1] * v0[1]) + (v0[2] * v0[2] + v0[3] * v0[3]) + (v1[0] * v1[0] + v1[1] * v1[1]) + (v1[2] * v1[2] + v1[3] * v1[3]); }
                        *(u32x4*)(O + (size_t)r * 1024 + cc + bj * HALF + 32 * wc + 8 * fq) = pack8(v0, v1); }
                    if (reg == 4) { s1 += __shfl_xor(s1, 16); s1 += __shfl_xor(s1, 32); s2 += __shfl_xor(s2, 16); s2 += __shfl_xor(s2, 32);
                        if (fq == 0) { atomicAdd(ln_s1 + r, s1); atomicAdd(ln_s2 + r, s2); } } }
        }
    }
};
template <class Epi, class Sched, bool ALIGN_EPI = false, bool SP2 = false>
__device__ __forceinline__ void gemm_phase(PG8_LAS unsigned char* lds, const Gemm g, const Sched& S, const Epi& E) {
    const int tid = threadIdx.x, wid = __builtin_amdgcn_readfirstlane(tid >> 6), lane = tid & 63, wr = wid >> 2, wc = wid & 3, fr = lane & 15, fq = lane >> 4;
    const int K = g.K, nt = K / BK;
    unsigned voffA[2], voffB[2];
#pragma unroll
    for (int i = 0; i < 2; ++i) { int R, C; stage_rc(tid * 16 + i * 8192, R, C); const int Rb = Epi::PERM ? ((R & ~31) + perm32(R & 31)) : R;
        voffA[i] = (unsigned)(R * K + C) * 2u; voffB[i] = (unsigned)(Rb * K + C) * 2u; }
    const size_t kstep = (size_t)(BK * 2);
    const size_t hstep = (size_t)HALF * K * 2;
    const size_t tstep = 2 * hstep;
    const unsigned ldsw = (unsigned)wid * 1024u;
    const int aoff = lds_byte(wr * 64 + fr, fq * 8), boff = lds_byte(wc * 32 + fr, fq * 8);
#define PG8_SA(b, h) (((b) * 2 + (h)) * HTB)
#define PG8_SB(b, h) ((4 + (b) * 2 + (h)) * HTB)
#define PG8_STAGE(bufoff, gbase, voff) do { _Pragma("unroll") for (int _i = 0; _i < 2; ++_i) \
        __builtin_amdgcn_global_load_lds((const unsigned*)((const char*)(gbase) + (voff)[_i]), (PG8_LAS unsigned*)(lds + (bufoff) + ldsw + _i * 8192), 16, 0, 0); } while (0)
#define PG8_LDA(dst, b, h) do { _Pragma("unroll") for (int m = 0; m < 4; ++m) _Pragma("unroll") for (int k = 0; k < 2; ++k) dst[m][k] = *(const PG8_LAS bf16x8*)(lds + PG8_SA(b, h) + aoff + m * 2048 + k * 1024); } while (0)
#define PG8_LDB(dst, b, h) do { _Pragma("unroll") for (int n = 0; n < 2; ++n) _Pragma("unroll") for (int k = 0; k < 2; ++k) dst[n][k] = *(const PG8_LAS bf16x8*)(lds + PG8_SB(b, h) + boff + n * 2048 + k * 1024); } while (0)
#define PG8_MMA(ai, bj, At, Bt) do { __builtin_amdgcn_s_setprio(1); _Pragma("unroll") for (int m = 0; m < 4; ++m) _Pragma("unroll") for (int n = 0; n < 2; ++n) _Pragma("unroll") for (int k = 0; k < 2; ++k) \
        acc[ai][bj][m][n] = __builtin_amdgcn_mfma_f32_16x16x32_bf16(Bt[n][k], At[m][k], acc[ai][bj][m][n], 0, 0, 0); __builtin_amdgcn_s_setprio(0); } while (0)
#define PG8_WAIT_V(n) asm volatile("s_waitcnt vmcnt(" #n ")" ::: "memory")
#define PG8_WAIT_L(n) asm volatile("s_waitcnt lgkmcnt(" #n ")" ::: "memory")
#define PG8_BAR __builtin_amdgcn_s_barrier()
#define PG8_SCHED __builtin_amdgcn_sched_barrier(0)
    Unit cur, nxt; int ui = 0;
    if (!S.next(0, cur)) return;
    f32x4 acc[2][2][4][2];
#pragma unroll
    for (int a = 0; a < 2; ++a)
#pragma unroll
        for (int b = 0; b < 2; ++b)
#pragma unroll
            for (int m = 0; m < 4; ++m)
#pragma unroll
                for (int n = 0; n < 2; ++n) acc[a][b][m][n] = (f32x4){0.f, 0.f, 0.f, 0.f};
    bf16x8 At[4][2], B0[2][2], B1[2][2];
    const char* cA = (const char*)g.A + (size_t)cur.pm * tstep; const char* cB = (const char*)g.Bt + (size_t)cur.pn * tstep;
    S.a_ready(cur);
    if constexpr (SP2) {
        PG8_STAGE(PG8_SB(0, 0), cB, voffB); PG8_STAGE(PG8_SB(0, 1), cB + hstep, voffB); PG8_STAGE(PG8_SA(0, 0), cA, voffA); PG8_STAGE(PG8_SA(0, 1), cA + hstep, voffA);
        if (wr == 1) PG8_BAR;
        PG8_WAIT_V(2); PG8_BAR;
        PG8_STAGE(PG8_SB(1, 0), cB + kstep, voffB); PG8_STAGE(PG8_SA(1, 0), cA + kstep, voffA); PG8_STAGE(PG8_SB(1, 1), cB + hstep + kstep, voffB);
        PG8_WAIT_V(6); PG8_BAR;
    } else {
        PG8_STAGE(PG8_SB(0, 0), cB, voffB); PG8_STAGE(PG8_SA(0, 0), cA, voffA); PG8_STAGE(PG8_SB(0, 1), cB + hstep, voffB); PG8_STAGE(PG8_SA(0, 1), cA + hstep, voffA);
        if (wr == 1) PG8_BAR;
        PG8_WAIT_V(4); PG8_BAR;
        PG8_STAGE(PG8_SB(1, 0), cB + kstep, voffB); PG8_STAGE(PG8_SA(1, 0), cA + kstep, voffA); PG8_STAGE(PG8_SB(1, 1), cB + hstep + kstep, voffB);
        PG8_WAIT_V(6); PG8_BAR;
    }
    for (;;) {
        const bool has_next = S.next(ui + 1, nxt);
        const char* nA = has_next ? (const char*)g.A + (size_t)nxt.pm * tstep : cA; const char* nB = has_next ? (const char*)g.Bt + (size_t)nxt.pn * tstep : cB;
        for (int t = 0; t < nt; t += 2) {
            if constexpr (Epi::MID) { if (t == (nt >> 1)) E.mid(acc, cur, wr, fr); }
            const bool last = (t == nt - 2);
            const char* a1 = cA + (size_t)(t + 1) * kstep;
            const char* a2 = last ? nA : cA + (size_t)(t + 2) * kstep; const char* b2 = last ? nB : cB + (size_t)(t + 2) * kstep;
            const char* a3 = a2 + kstep; const char* b3 = b2 + kstep;
            if (last && has_next) S.a_ready(nxt);
            if constexpr (SP2) {
            PG8_LDB(B0, 0, 0); PG8_LDB(B1, 0, 1); PG8_SCHED; PG8_LDA(At, 0, 0); PG8_STAGE(PG8_SA(1, 1), a1 + hstep, voffA);
            PG8_WAIT_V(8); PG8_WAIT_L(0); PG8_BAR; PG8_MMA(0, 0, At, B0); PG8_MMA(0, 1, At, B1); PG8_BAR; PG8_SCHED;
            PG8_LDA(At, 0, 1); PG8_STAGE(PG8_SB(0, 0), b2, voffB); PG8_STAGE(PG8_SB(0, 1), b2 + hstep, voffB); PG8_STAGE(PG8_SA(0, 0), a2, voffA);
            PG8_WAIT_V(8); PG8_WAIT_L(0); PG8_BAR; PG8_MMA(1, 0, At, B0); PG8_MMA(1, 1, At, B1); PG8_BAR; PG8_SCHED;
            PG8_LDB(B0, 1, 0); PG8_LDB(B1, 1, 1); PG8_SCHED; PG8_LDA(At, 1, 0); PG8_STAGE(PG8_SA(0, 1), a2 + hstep, voffA);
            PG8_WAIT_V(8); PG8_WAIT_L(0); PG8_BAR; PG8_MMA(0, 0, At, B0); PG8_MMA(0, 1, At, B1); PG8_BAR; PG8_SCHED;
            PG8_LDA(At, 1, 1); PG8_STAGE(PG8_SB(1, 0), b3, voffB); PG8_STAGE(PG8_SB(1, 1), b3 + hstep, voffB); PG8_STAGE(PG8_SA(1, 0), a3, voffA);
            PG8_WAIT_V(8); PG8_WAIT_L(0); PG8_BAR; PG8_MMA(1, 0, At, B0); PG8_MMA(1, 1, At, B1); PG8_BAR; PG8_SCHED;
            } else {
            PG8_LDB(B0, 0, 0); PG8_SCHED; PG8_LDA(At, 0, 0); PG8_STAGE(PG8_SA(1, 1), a1 + hstep, voffA);
            PG8_WAIT_L(8); PG8_BAR; PG8_WAIT_L(0); PG8_MMA(0, 0, At, B0); PG8_BAR; PG8_SCHED;
            PG8_LDB(B1, 0, 1); PG8_STAGE(PG8_SB(0, 0), b2, voffB);
            PG8_BAR; PG8_WAIT_L(0); PG8_MMA(0, 1, At, B1); PG8_BAR;
            PG8_LDA(At, 0, 1); PG8_STAGE(PG8_SA(0, 0), a2, voffA);
            PG8_BAR; PG8_WAIT_L(0); PG8_MMA(1, 0, At, B0); PG8_BAR; PG8_SCHED;
            PG8_STAGE(PG8_SB(0, 1), b2 + hstep, voffB);
            PG8_WAIT_V(6); PG8_BAR; PG8_MMA(1, 1, At, B1); PG8_BAR;
            PG8_LDB(B0, 1, 0); PG8_SCHED; PG8_LDA(At, 1, 0); PG8_STAGE(PG8_SA(0, 1), a2 + hstep, voffA);
            PG8_WAIT_L(8); PG8_BAR; PG8_WAIT_L(0); PG8_MMA(0, 0, At, B0); PG8_BAR; PG8_SCHED;
            PG8_LDB(B1, 1, 1); PG8_STAGE(PG8_SB(1, 0), b3, voffB);
            PG8_BAR; PG8_WAIT_L(0); PG8_MMA(0, 1, At, B1); PG8_BAR;
            PG8_LDA(At, 1, 1); PG8_STAGE(PG8_SA(1, 0), a3, voffA);
            PG8_BAR; PG8_WAIT_L(0); PG8_MMA(1, 0, At, B0); PG8_BAR; PG8_SCHED;
            PG8_STAGE(PG8_SB(1, 1), b3 + hstep, voffB);
            PG8_WAIT_V(6); PG8_BAR; PG8_MMA(1, 1, At, B1); PG8_BAR;
            }
        }
        if constexpr (ALIGN_EPI) { if (wr == 0) PG8_BAR; }
        if constexpr (!Epi::AFTER_DRAIN) { E(acc, cur, wr, wc, fr, fq); S.done(cur); }
        if (!has_next) break;
#pragma unroll
        for (int a = 0; a < 2; ++a)
#pragma unroll
            for (int b = 0; b < 2; ++b)
#pragma unroll
                for (int m = 0; m < 4; ++m)
#pragma unroll
                    for (int n = 0; n < 2; ++n) acc[a][b][m][n] = (f32x4){0.f, 0.f, 0.f, 0.f};
        cur = nxt; cA = nA; cB = nB; ++ui;
        if constexpr (ALIGN_EPI) { if (wr == 1) PG8_BAR; }
    }
    PG8_WAIT_V(0);
    if constexpr (!ALIGN_EPI) { if (wr == 0) PG8_BAR; }
    PG8_BAR;
    if constexpr (Epi::AFTER_DRAIN) { E.fused(acc, cur, wr, wc, fr, fq, lds, wid, lane); S.done(cur); }
#undef PG8_SA
#undef PG8_SB
#undef PG8_STAGE
#undef PG8_LDA
#undef PG8_LDB
#undef PG8_MMA
#undef PG8_WAIT_V
#undef PG8_WAIT_L
#undef PG8_BAR
#undef PG8_SCHED
}
}

constexpr int NWAVES = 8;
constexpr int S_ = 8192, DM = 2048, DFF = 5632, NMEM = 256, DIN = 5120, AW = 1024;
constexpr size_t MiB = 1u << 20;
constexpr size_t WS_CTL = 0, WS_COS = 1 * MiB, WS_SIN = 2 * MiB, WS_MK = 3 * MiB, WS_KVM = 4 * MiB;
constexpr size_t WS_WGU1 = 6 * MiB, WS_WD1 = 50 * MiB, WS_WGU2 = 72 * MiB, WS_WD2 = 116 * MiB, WS_WIN = 138 * MiB, WS_WOUT = 158 * MiB, WS_WQ = 166 * MiB, WS_WKV = 174 * MiB, WS_WO = 190 * MiB;
constexpr size_t WS_XN = 198 * MiB, WS_MIXED = 230 * MiB, WS_OB = 262 * MiB, WS_LSE = 310 * MiB, WS_ACT = 312 * MiB, WS_END = 400 * MiB;
constexpr size_t WS_Q = WS_ACT, WS_K = WS_ACT + 16 * MiB, WS_V = WS_ACT + 32 * MiB, WS_U = WS_ACT + 48 * MiB, WS_GV = WS_ACT + 64 * MiB;
constexpr size_t WS_QM = WS_ACT, WS_OM = WS_ACT + 32 * MiB;
enum { SS_X = 0, SS_H1, LN_S1, LN_S2, SS_A, SS_S, SS_H2, SS_H3, SS_H4, SS_N };
#ifndef USE_MFMA_ATTN
#define USE_MFMA_ATTN 1
#endif
#ifndef USE_MFMA_SGU
#define USE_MFMA_SGU 1
#endif
#ifndef USE_MFMA_XATTN
#define USE_MFMA_XATTN 1
#endif
constexpr int RING_BYTES = 131072, LDS_BYTES = 147456;

#define LAS __attribute__((address_space(3)))
typedef unsigned short bf16;
typedef unsigned v4u __attribute__((ext_vector_type(4)));
typedef unsigned v2u __attribute__((ext_vector_type(2)));
typedef float f32x4 __attribute__((ext_vector_type(4)));
typedef short bf16x8 __attribute__((ext_vector_type(8)));
#define LDS_WAIT() asm volatile("s_waitcnt lgkmcnt(0)" ::: "memory")
__device__ __forceinline__ unsigned f2bf(float f) { unsigned u = __builtin_bit_cast(unsigned, f); return (u + 0x7fffu + ((u >> 16) & 1u)) >> 16; }
__device__ __forceinline__ unsigned pk2(float lo, float hi) { return f2bf(lo) | (f2bf(hi) << 16); }
__device__ __forceinline__ float bf2f(unsigned short b) { return __uint_as_float((unsigned)b << 16); }
__device__ __forceinline__ float wave_sum(float v) {
#pragma unroll
    for (int o = 1; o < 64; o <<= 1) v += __shfl_xor(v, o);
    return v;
}
__device__ __forceinline__ float wave_max(float v) {
#pragma unroll
    for (int o = 1; o < 64; o <<= 1) v = fmaxf(v, __shfl_xor(v, o));
    return v;
}

__constant__ double INVF[32] = {1.0, 0.7498942093324559, 0.5623413251903491, 0.4216965034285822, 0.31622776601683794, 0.23713737056616552, 0.1778279410038923, 0.1333521432163324, 0.1, 0.07498942093324558, 0.05623413251903491, 0.042169650342858224, 0.03162277660168379, 0.023713737056616554, 0.01778279410038923, 0.01333521432163324, 0.01, 0.007498942093324558, 0.005623413251903491, 0.004216965034285823, 0.0031622776601683794, 0.0023713737056616554, 0.0017782794100389228, 0.001333521432163324, 0.001, 0.0007498942093324559, 0.0005623413251903491, 0.00042169650342858224, 0.00031622776601683794, 0.00023713737056616554, 0.00017782794100389227, 0.0001333521432163324};

struct Args { const void* in[27]; float* out; unsigned char* ws; int ph_lo, ph_hi; };

#define XB_TMO      128
#define XB_XCNT(j)  (256  + 64 * (j))
#define XB_XSUB(j)  (1280 + 64 * (j))
#define XB_XGEN(j)  (2304 + 64 * (j))
#define XB_TOP      3328
#define XB_TOPGEN   3392
#define XCD_BAR_WORDS 3456
#define XB_SPIN_CAP (1u << 18)

__device__ __forceinline__ unsigned xb_ld(unsigned* p)              { return __hip_atomic_load(p, __ATOMIC_RELAXED, __HIP_MEMORY_SCOPE_AGENT); }
__device__ __forceinline__ unsigned xb_add(unsigned* p, unsigned v) { return __hip_atomic_fetch_add(p, v, __ATOMIC_RELAXED, __HIP_MEMORY_SCOPE_AGENT); }
__device__ __forceinline__ unsigned xb_xcc_id() { return (unsigned)__builtin_amdgcn_s_getreg((3 << 11) | 20) & 0xFu; }
#define XB_SPIN(cond, bar) do { unsigned _sp = 0; while (cond) { __builtin_amdgcn_s_sleep(1); \
    if ((++_sp & 255u) == 0u) { if (xb_ld(&(bar)[XB_TMO])) break; if (_sp > XB_SPIN_CAP) { atomicAdd(&(bar)[XB_TMO], 1u); break; } } } } while (0)

struct XcdBarrier {
    unsigned* bar; unsigned x;
    volatile LAS unsigned* st;
};

__device__ __forceinline__ XcdBarrier xcd_barrier_post(unsigned* bar, volatile LAS unsigned* st) {
    XcdBarrier b; b.bar = bar; b.x = xb_xcc_id(); b.st = st;
    if (threadIdx.x == 0) (void)xb_add(&bar[XB_XCNT(b.x)], 1u);
    return b;
}
__device__ __forceinline__ void xcd_barrier_complete(unsigned* bar, unsigned x, unsigned& nloc, unsigned& nx) {
    const unsigned G = gridDim.x * gridDim.y * gridDim.z;
    unsigned sum, cnt, mine, sp = 0u;
    for (;;) {
        sum = 0u; cnt = 0u; mine = 0u;
#pragma unroll
        for (unsigned j = 0; j < 16; ++j) { const unsigned c = xb_ld(&bar[XB_XCNT(j)]); sum += c; cnt += (c > 0u) ? 1u : 0u; mine = (j == x) ? c : mine; }
        if (sum == G) break;
        __builtin_amdgcn_s_sleep(1);
        if ((++sp & 255u) == 0u) { if (xb_ld(&bar[XB_TMO])) break; if (sp > XB_SPIN_CAP) { atomicAdd(&bar[XB_TMO], 1u); break; } }
    }
    nloc = mine > 0u ? mine : 1u; nx = cnt > 0u ? cnt : 1u;
}

__device__ __forceinline__ void xcd_barrier(const XcdBarrier& b) {
    asm volatile("s_waitcnt vmcnt(0)" ::: "memory");
    __syncthreads();
    if (threadIdx.x == 0) {
        unsigned* bar = b.bar;
        __builtin_amdgcn_s_waitcnt(0);
        unsigned nloc = b.st[0], nx = b.st[1];
        if (nloc == 0u) { xcd_barrier_complete(bar, b.x, nloc, nx); b.st[0] = nloc; b.st[1] = nx; }
        const unsigned old = xb_add(&bar[XB_XSUB(b.x)], 1u);
        const unsigned gen = old / nloc;
        if (old + 1u == (gen + 1u) * nloc) {
            __builtin_amdgcn_fence(__ATOMIC_RELEASE, "agent");
            asm volatile("s_waitcnt vmcnt(0)" ::: "memory");
            const unsigned og = xb_add(&bar[XB_TOP], 1u);
            const unsigned tg = og / nx;
            if (og + 1u == (tg + 1u) * nx) xb_add(&bar[XB_TOPGEN], 1u);
            else XB_SPIN(xb_ld(&bar[XB_TOPGEN]) == tg, bar);
            __builtin_amdgcn_fence(__ATOMIC_ACQUIRE, "agent");
            xb_add(&bar[XB_XGEN(b.x)], 1u);
            asm volatile("s_waitcnt vmcnt(0)" ::: "memory");
        } else {
            XB_SPIN(xb_ld(&bar[XB_XGEN(b.x)]) == gen, bar);
            __builtin_amdgcn_fence(__ATOMIC_ACQUIRE, "agent");
            asm volatile("s_waitcnt vmcnt(0)" ::: "memory");
        }
    }
    __syncthreads();
}

__device__ __forceinline__ int dst_row(int mode, int row_off, int n) {
    if (mode == 1 || mode == 2) return (n >> 7) * 256 + (mode == 2 ? 128 : 0) + (n & 127);
    if (mode == 3 && n < 2048) return (n >> 8) * 256 + ((n >> 5) & 1) * 128 + ((n >> 6) & 3) * 32 + (n & 31);
    return row_off + n;
}
__device__ __forceinline__ void tr_job(const float* W, int K, int N, const float* g1, const float* g2, bf16* WT, int row_off, int mode, int item, LAS float* scr, int lane) {
    const int nblk = N / 64, kb = item / nblk, nb = item % nblk, k0 = 64 * kb, n0 = 64 * nb;
    const float* gain = g1; if (g2 && k0 >= 1024) gain = g2 - 1024;
    f32x4 v[16];
    const int kl = lane >> 4, n4 = (lane & 15) * 4;
#pragma unroll
    for (int i = 0; i < 16; ++i) v[i] = *(const f32x4*)(W + (size_t)(k0 + 4 * i + kl) * N + n0 + n4);
    if (gain) {
#pragma unroll
        for (int i = 0; i < 16; ++i) v[i] = v[i] * gain[k0 + 4 * i + kl];
    }
#pragma unroll
    for (int i = 0; i < 16; ++i) { const int k = 4 * i + kl; *(LAS f32x4*)(scr + k * 68 + (n4 ^ (((k >> 3) & 7) << 2))) = v[i]; }
    LDS_WAIT(); asm volatile("" ::: "memory");
    const int c = lane & 7, nn = lane >> 3;
#pragma unroll
    for (int j = 0; j < 8; ++j) { const int n = nn + 8 * j; const LAS float* sp = scr + (8 * c) * 68 + (n ^ (c << 2));
        v4u o; o.x = pk2(sp[0 * 68], sp[1 * 68]); o.y = pk2(sp[2 * 68], sp[3 * 68]); o.z = pk2(sp[4 * 68], sp[5 * 68]); o.w = pk2(sp[6 * 68], sp[7 * 68]);
        *(v4u*)(WT + (size_t)dst_row(mode, row_off, n0 + n) * K + k0 + 8 * c) = o; }
    LDS_WAIT(); asm volatile("" ::: "memory");
}

__device__ __forceinline__ void attn_naive(LAS unsigned char* lds, const bf16* Q, const bf16* K, const bf16* V, bf16* MIXED, float* ss_a, int gw, int NGW, int wave, int lane) {
    LAS float* qs = (LAS float*)lds + wave * 64;
    for (int wu = gw; wu < S_ * 16; wu += NGW) {
        const int t = wu >> 4, h = wu & 15;
        qs[lane] = bf2f(Q[(size_t)t * AW + h * 64 + lane]);
        LDS_WAIT(); asm volatile("" ::: "memory");
        float sc[9];
#pragma unroll
        for (int b = 0; b < 3; ++b)
#pragma unroll
            for (int p = 0; p < 3; ++p) {
                const int diff = 64 * p + lane, kt = t - (diff << (2 * b)); const bool valid = (diff <= 128) && (kt >= 0);
                float dot = 0.f;
                if (valid) { const bf16x8* kr = (const bf16x8*)(K + (size_t)kt * AW + h * 64);
#pragma unroll
                    for (int c = 0; c < 8; ++c) { const bf16x8 kv = kr[c];
#pragma unroll
                        for (int e = 0; e < 8; ++e) dot += qs[8 * c + e] * bf2f((unsigned short)kv[e]); } }
                sc[b * 3 + p] = valid ? dot * 0.125f : -INFINITY;
            }
        float m = sc[0];
#pragma unroll
        for (int i = 1; i < 9; ++i) m = fmaxf(m, sc[i]);
        m = wave_max(m);
        float l = 0.f;
#pragma unroll
        for (int i = 0; i < 9; ++i) { sc[i] = __expf(sc[i] - m); l += sc[i]; }
        l = wave_sum(l);
        float o = 0.f;
#pragma unroll
        for (int b = 0; b < 3; ++b)
#pragma unroll
            for (int p = 0; p < 3; ++p) {
                const int pbits = __float_as_int(sc[b * 3 + p]);
                for (int j = 0; j < 64; ++j) { const int diff = 64 * p + j, kt = t - (diff << (2 * b));
                    if (diff <= 128 && kt >= 0) { const float pj = __int_as_float(__builtin_amdgcn_readlane(pbits, j)); o += pj * bf2f(V[(size_t)kt * AW + h * 64 + lane]); } }
            }
        o = o / l;
        MIXED[(size_t)t * DM + h * 64 + lane] = (bf16)f2bf(o);
        const float q = wave_sum(o * o); if (lane == 0) atomicAdd(ss_a + t, q);
        asm volatile("" ::: "memory");
    }
}

__device__ __forceinline__ void sgu_naive(LAS unsigned char* lds, const bf16* U, const bf16* GV, const float* ln_s1, const float* ln_s2, const float* ln_g, const float* ln_b, const float* w_s, const float* b_s,
                                          bf16* MIXED, float* ss_s, int bx, int G, int tid, int lane) {
    LAS float* GT = (LAS float*)lds;
    LAS float* WL = (LAS float*)(lds + 65536);
    for (int unit = bx; unit < 64 * 8; unit += G) {
        const int c = unit >> 3, g = unit & 7;
        for (int idx = tid; idx < 128 * 128; idx += NWAVES * 64) {
            const int j = idx >> 7, d = idx & 127, tok = c * 128 + j, ch = g * 128 + d;
            const float mean = ln_s1[tok] * (1.0f / AW), var = ln_s2[tok] * (1.0f / AW) - mean * mean, rstd = 1.0f / sqrtf(var + 1e-6f);
            GT[idx] = (bf2f(GV[(size_t)tok * AW + ch]) - mean) * rstd * ln_g[ch] + ln_b[ch];
            WL[idx] = (d <= j) ? w_s[(size_t)g * 16384 + idx] : 0.f;
        }
        __syncthreads();
        const int d = tid & 127, iq = tid >> 7;
        for (int ii = 0; ii < 32; ++ii) {
            const int i = iq * 32 + ii; float acc = 0.f;
            for (int j = 0; j <= i; ++j) acc += WL[i * 128 + j] * GT[j * 128 + d];
            const int tok = c * 128 + i; const float sv = acc + b_s[g * 128 + i];
            const float o = bf2f(U[(size_t)tok * AW + g * 128 + d]) * sv;
            MIXED[(size_t)tok * DM + AW + g * 128 + d] = (bf16)f2bf(o);
            const float q = wave_sum(o * o); if (lane == 0) atomicAdd(ss_s + tok, q);
        }
        __syncthreads();
    }
}

__device__ __forceinline__ void xattn_naive(LAS unsigned char* lds, const bf16* QM, const bf16* KVM, bf16* OM, int gw, int NGW, int wave, int lane) {
    LAS float* qs = (LAS float*)lds + wave * 512;
    for (int wu = gw; wu < S_ * 4; wu += NGW) {
        const int t = wu >> 2, h = wu & 3;
        { const bf16x8 qv = *(const bf16x8*)(QM + (size_t)t * DM + h * 512 + lane * 8);
#pragma unroll
          for (int e = 0; e < 8; ++e) qs[lane * 8 + e] = bf2f((unsigned short)qv[e]); }
        LDS_WAIT(); asm volatile("" ::: "memory");
        float sc[4];
#pragma unroll
        for (int p = 0; p < 4; ++p) {
            const bf16x8* kr = (const bf16x8*)(KVM + (size_t)(64 * p + lane) * (2 * DM) + h * 512); float dot = 0.f;
            for (int c = 0; c < 64; ++c) { const bf16x8 kv = kr[c];
#pragma unroll
                for (int e = 0; e < 8; ++e) dot += qs[8 * c + e] * bf2f((unsigned short)kv[e]); }
            sc[p] = dot * 0.044194173824159216f;
        }
        float m = wave_max(fmaxf(fmaxf(sc[0], sc[1]), fmaxf(sc[2], sc[3])));
        float l = 0.f;
#pragma unroll
        for (int p = 0; p < 4; ++p) { sc[p] = __expf(sc[p] - m); l += sc[p]; }
        l = wave_sum(l);
        float o[8];
#pragma unroll
        for (int e = 0; e < 8; ++e) o[e] = 0.f;
#pragma unroll
        for (int p = 0; p < 4; ++p) { const int pbits = __float_as_int(sc[p]);
            for (int j = 0; j < 64; ++j) { const float pj = __int_as_float(__builtin_amdgcn_readlane(pbits, j));
                const bf16x8 vv = *(const bf16x8*)(KVM + (size_t)(64 * p + j) * (2 * DM) + DM + h * 512 + lane * 8);
#pragma unroll
                for (int e = 0; e < 8; ++e) o[e] += pj * bf2f((unsigned short)vv[e]); } }
        const float il = 1.0f / l;
        v4u w; w.x = pk2(o[0] * il, o[1] * il); w.y = pk2(o[2] * il, o[3] * il); w.z = pk2(o[4] * il, o[5] * il); w.w = pk2(o[6] * il, o[7] * il);
        *(v4u*)(OM + (size_t)t * DM + h * 512 + lane * 8) = w;
        asm volatile("" ::: "memory");
    }
}

typedef short v4s __attribute__((ext_vector_type(4)));
__device__ __forceinline__ v4s tr_read8(LAS unsigned char* p) { return __builtin_amdgcn_ds_read_tr16_b64_v4i16((LAS v4s*)p); }
__device__ __forceinline__ bf16x8 join8(v4s lo, v4s hi) { return (bf16x8){lo[0], lo[1], lo[2], lo[3], hi[0], hi[1], hi[2], hi[3]}; }
__device__ __forceinline__ unsigned cvtpk(float lo, float hi) { unsigned r; asm volatile("v_cvt_pk_bf16_f32 %0, %1, %2" : "=v"(r) : "v"(lo), "v"(hi)); return r; }
__device__ __forceinline__ bf16x8 packP(const f32x4 a, const f32x4 b) { v4u w; w.x = cvtpk(a[0], a[1]); w.y = cvtpk(a[2], a[3]); w.z = cvtpk(b[0], b[1]); w.w = cvtpk(b[2], b[3]); return __builtin_bit_cast(bf16x8, w); }
#define MFMA16(a, b, c) __builtin_amdgcn_mfma_f32_16x16x32_bf16((a), (b), (c), 0, 0, 0)
constexpr int KV_PB = 144, KV_TILE = 256 * KV_PB;

__device__ __forceinline__ void dattn_mfma(LAS unsigned char* lds, const bf16* Q, const bf16* K, const bf16* V, bf16* OB, float* LSE, int bx, int G, int tid, int wave, int lane) {
    asm volatile("" : "+v"(tid), "+v"(lane), "+s"(wave), "+s"(bx));
    const int g = lane >> 4, i16 = lane & 15, q4 = i16 >> 2, p4 = lane & 3;
    LAS unsigned char* Ks = lds; LAS unsigned char* Vs = lds + KV_TILE;
    LAS unsigned char* kbase = Ks + (16 * wave + i16) * KV_PB + g * 16; LAS unsigned char* vbase = Vs + (16 * wave + 4 * g + q4) * KV_PB + p4 * 8;
    const int kj0 = 16 * wave + 4 * g, dl0 = i16 - 4 * g;
    constexpr int NU = 3 * 16 * 64;
    v4u kreg[4], vreg[4]; bf16x8 qn0, qn1;
#define DA_DECODE(u, b, h, r, n, dsh) const int b = (u) >> 10, h = (u) & 15, dsh = 2 * b, r = (((u) & 1023) >> 4) & ((1 << dsh) - 1), n = (((u) & 1023) >> 4) >> dsh
#define DA_GLOAD(u) do { DA_DECODE(u, b_, h_, r_, n_, dsh_); (void)b_; _Pragma("unroll") for (int i = 0; i < 4; ++i) { const int id = tid + 512 * i, row = id >> 3, ch = id & 7, s = 128 * (n_ - 1) + row; \
        if (s >= 0) { const size_t off = ((size_t)r_ + ((size_t)s << dsh_)) * AW + h_ * 64 + ch * 8; kreg[i] = *(const v4u*)(K + off); vreg[i] = *(const v4u*)(V + off); } \
        else { kreg[i] = (v4u){0u, 0u, 0u, 0u}; vreg[i] = (v4u){0u, 0u, 0u, 0u}; } } \
        { const size_t qt_ = (size_t)r_ + ((size_t)(128 * n_ + 16 * wave + i16) << dsh_); qn0 = *(const bf16x8*)(Q + qt_ * AW + h_ * 64 + 8 * g); qn1 = *(const bf16x8*)(Q + qt_ * AW + h_ * 64 + 32 + 8 * g); } } while (0)
    int u = bx;
    if (u < NU) DA_GLOAD(u);
    for (; u < NU; u += G) {
#pragma unroll
        for (int i = 0; i < 4; ++i) { const int id = tid + 512 * i, row = id >> 3, ch = id & 7; *(LAS v4u*)(Ks + row * KV_PB + ch * 16) = kreg[i]; *(LAS v4u*)(Vs + row * KV_PB + ch * 16) = vreg[i]; }
        const bf16x8 qf0 = qn0, qf1 = qn1;
        __syncthreads();
        if (u + G < NU) DA_GLOAD(u + G);
        DA_DECODE(u, b, h, r, n, dsh);
        const int qi = 16 * wave + i16;
        const size_t qtok = (size_t)r + ((size_t)(128 * n + qi) << dsh);
        f32x4 s[9];
#pragma unroll
        for (int t = 0; t < 9; ++t) { LAS unsigned char* kp = kbase + t * (16 * KV_PB);
            const bf16x8 k0 = *(LAS bf16x8*)kp, k1 = *(LAS bf16x8*)(kp + 64);
            s[t] = MFMA16(k0, qf0, ((f32x4){0.f, 0.f, 0.f, 0.f})); s[t] = MFMA16(k1, qf1, s[t]); }
        float mx = -INFINITY;
#pragma unroll
        for (int t = 0; t < 9; ++t)
#pragma unroll
            for (int e = 0; e < 4; ++e) { const int kj = kj0 + (16 * t + e), diff = dl0 + (128 - 16 * t - e); const bool valid = (diff >= 0) && (diff <= 128) && (n > 0 || kj >= 128);
                const float v = valid ? s[t][e] * (0.125f * 1.4426950408889634f) : -INFINITY; s[t][e] = v; mx = fmaxf(mx, v); }
        mx = fmaxf(mx, __shfl_xor(mx, 16)); mx = fmaxf(mx, __shfl_xor(mx, 32));
        float l = 0.f;
#pragma unroll
        for (int t = 0; t < 9; ++t)
#pragma unroll
            for (int e = 0; e < 4; ++e) { const float p = __builtin_amdgcn_exp2f(s[t][e] - mx); s[t][e] = p; l += p; }
        l += __shfl_xor(l, 16); l += __shfl_xor(l, 32);
        f32x4 o[4];
#pragma unroll
        for (int dt = 0; dt < 4; ++dt) o[dt] = (f32x4){0.f, 0.f, 0.f, 0.f};
#pragma unroll
        for (int c = 0; c < 5; ++c) {
            const bf16x8 pf = packP(s[2 * c], (2 * c + 1 < 9) ? s[(2 * c + 1 < 9) ? 2 * c + 1 : 8] : (f32x4){0.f, 0.f, 0.f, 0.f});
            LAS unsigned char* va = vbase + (2 * c) * (16 * KV_PB); LAS unsigned char* vb = vbase + ((2 * c + 1 < 9) ? (2 * c + 1) : (2 * c)) * (16 * KV_PB);
#pragma unroll
            for (int dt = 0; dt < 4; ++dt) { const v4s lo = tr_read8(va + dt * 32), hi = tr_read8(vb + dt * 32); o[dt] = MFMA16(join8(lo, hi), pf, o[dt]); }
        }
        const float il = 1.0f / l;
        bf16* op = OB + ((size_t)b * S_ + qtok) * AW + h * 64 + 4 * g;
#pragma unroll
        for (int dt = 0; dt < 4; ++dt) { v2u w; w.x = cvtpk(o[dt][0] * il, o[dt][1] * il); w.y = cvtpk(o[dt][2] * il, o[dt][3] * il); *(v2u*)(op + 16 * dt) = w; }
        if (g == 0) LSE[((size_t)b * S_ + qtok) * 16 + h] = mx + __builtin_amdgcn_logf(l);
        __syncthreads();
    }
#undef DA_DECODE
#undef DA_GLOAD
}

__device__ __forceinline__ void sgu_mfma(LAS unsigned char* lds, const bf16* U, const bf16* GV, const float* ln_s1, const float* ln_s2, const float* ln_g, const float* ln_b, const float* w_s, const float* b_s,
                                         bf16* MIXED, float* ss_s, int bx, int G, int tid, int wave, int lane) {
    asm volatile("" : "+v"(tid), "+v"(lane), "+s"(wave), "+s"(bx));
    const int g = lane >> 4, i16 = lane & 15, q4 = i16 >> 2, p4 = lane & 3;
    constexpr int PB = 272;
    LAS unsigned char* GN = lds; LAS unsigned char* WS = lds + 128 * PB;
    LAS unsigned char* gbase = GN + (8 * g + q4) * PB + (16 * wave + 4 * p4) * 2; LAS unsigned char* wbase = WS + i16 * PB + (8 * g) * 2;
    for (int unit = bx; unit < 64 * 8; unit += G) {
        const int c = unit >> 3, grp = unit & 7;
#pragma unroll
        for (int k = 0; k < 4; ++k) { const int id = tid + 512 * k, j = id >> 4, ch = id & 15, tok = c * 128 + j;
            const bf16x8 gv = *(const bf16x8*)(GV + (size_t)tok * AW + grp * 128 + 8 * ch);
            const float mean = ln_s1[tok] * (1.0f / AW), var = ln_s2[tok] * (1.0f / AW) - mean * mean, rstd = 1.0f / sqrtf(var + 1e-6f);
            const f32x4 lg0 = *(const f32x4*)(ln_g + grp * 128 + 8 * ch), lg1 = *(const f32x4*)(ln_g + grp * 128 + 8 * ch + 4), lb0 = *(const f32x4*)(ln_b + grp * 128 + 8 * ch), lb1 = *(const f32x4*)(ln_b + grp * 128 + 8 * ch + 4);
            f32x4 x0, x1;
#pragma unroll
            for (int e = 0; e < 4; ++e) { x0[e] = (bf2f((unsigned short)gv[e]) - mean) * rstd * lg0[e] + lb0[e]; x1[e] = (bf2f((unsigned short)gv[4 + e]) - mean) * rstd * lg1[e] + lb1[e]; }
            *(LAS bf16x8*)(GN + j * PB + ch * 16) = packP(x0, x1);
            f32x4 w0 = *(const f32x4*)(w_s + (size_t)grp * 16384 + j * 128 + 8 * ch), w1 = *(const f32x4*)(w_s + (size_t)grp * 16384 + j * 128 + 8 * ch + 4);
#pragma unroll
            for (int e = 0; e < 4; ++e) { if (8 * ch + e > j) w0[e] = 0.f; if (8 * ch + 4 + e > j) w1[e] = 0.f; }
            *(LAS bf16x8*)(WS + j * PB + ch * 16) = packP(w0, w1); }
        __syncthreads();
        f32x4 acc[8];
#pragma unroll
        for (int it = 0; it < 8; ++it) acc[it] = (f32x4){0.f, 0.f, 0.f, 0.f};
#pragma unroll
        for (int ks = 0; ks < 4; ++ks) {
            const v4s lo = tr_read8(gbase + (32 * ks) * PB), hi = tr_read8(gbase + (32 * ks + 4) * PB);
            const bf16x8 gf = join8(lo, hi);
#pragma unroll
            for (int it = 0; it < 8; ++it) if (it >= 2 * ks) { const bf16x8 wf = *(LAS bf16x8*)(wbase + (16 * it) * PB + (32 * ks) * 2); acc[it] = MFMA16(gf, wf, acc[it]); }
        }
#pragma unroll
        for (int it = 0; it < 8; ++it) { const int i = 16 * it + i16, tok = c * 128 + i, chn = grp * 128 + 16 * wave + 4 * g; const float bias = b_s[grp * 128 + i];
            const v2u uu = *(const v2u*)(U + (size_t)tok * AW + chn);
            const float o0 = bf2f((unsigned short)(uu.x & 0xffff)) * (acc[it][0] + bias), o1 = bf2f((unsigned short)(uu.x >> 16)) * (acc[it][1] + bias);
            const float o2 = bf2f((unsigned short)(uu.y & 0xffff)) * (acc[it][2] + bias), o3 = bf2f((unsigned short)(uu.y >> 16)) * (acc[it][3] + bias);
            v2u w; w.x = cvtpk(o0, o1); w.y = cvtpk(o2, o3); *(v2u*)(MIXED + (size_t)tok * DM + AW + chn) = w;
            float q = (o0 * o0 + o1 * o1) + (o2 * o2 + o3 * o3); q += __shfl_xor(q, 16); q += __shfl_xor(q, 32);
            if (g == 0) atomicAdd(ss_s + tok, q); }
        __syncthreads();
    }
}

__device__ __forceinline__ void xattn_mfma(LAS unsigned char* lds, const bf16* QM, const bf16* KVM, bf16* OM, int bx, int G, int tid, int wave, int lane) {
    asm volatile("" : "+v"(tid), "+v"(lane), "+s"(wave), "+s"(bx));
    const int g = lane >> 4, i16 = lane & 15, q4 = i16 >> 2, p4 = lane & 3;
    v4u reg[4];
    const int koff = i16 * KV_PB + g * 16, voff = (4 * g + q4) * KV_PB + p4 * 8;
#define XA_GLOAD(c) do { _Pragma("unroll") for (int i = 0; i < 4; ++i) { const int id = tid + 512 * i, row = id >> 3, ch = id & 7; \
        reg[i] = *(const v4u*)(KVM + (size_t)row * (2 * DM) + (((c) >> 3) ? DM : 0) + h * 512 + 64 * ((c) & 7) + ch * 8); } } while (0)
#define XA_WRITE(buf) do { _Pragma("unroll") for (int i = 0; i < 4; ++i) { const int id = tid + 512 * i, row = id >> 3, ch = id & 7; *(LAS v4u*)((buf) + row * KV_PB + ch * 16) = reg[i]; } } while (0)
    for (int unit = bx; unit < 256; unit += G) {
        const int h = unit & 3, qt = unit >> 2;
        const size_t tokq = (size_t)128 * qt + 16 * wave + i16;
        XA_GLOAD(0);
        bf16x8 qf[16];
#pragma unroll
        for (int c = 0; c < 8; ++c) { qf[2 * c] = *(const bf16x8*)(QM + tokq * DM + h * 512 + 64 * c + 8 * g); qf[2 * c + 1] = *(const bf16x8*)(QM + tokq * DM + h * 512 + 64 * c + 32 + 8 * g); }
        XA_WRITE(lds); __syncthreads();
        f32x4 s[16];
#pragma unroll
        for (int kt = 0; kt < 16; ++kt) s[kt] = (f32x4){0.f, 0.f, 0.f, 0.f};
#pragma unroll
        for (int c = 0; c < 8; ++c) {
            XA_GLOAD(c + 1);
            LAS unsigned char* buf = lds + (c & 1) * KV_TILE;
            const bf16x8 qf0 = qf[2 * c], qf1 = qf[2 * c + 1];
#pragma unroll
            for (int kt = 0; kt < 16; ++kt) { LAS unsigned char* kp = buf + koff + kt * (16 * KV_PB);
                const bf16x8 k0 = *(LAS bf16x8*)kp, k1 = *(LAS bf16x8*)(kp + 64); s[kt] = MFMA16(k0, qf0, s[kt]); s[kt] = MFMA16(k1, qf1, s[kt]); }
            XA_WRITE(lds + ((c + 1) & 1) * KV_TILE);
            __syncthreads();
        }
        float mx = -INFINITY;
#pragma unroll
        for (int kt = 0; kt < 16; ++kt)
#pragma unroll
            for (int e = 0; e < 4; ++e) { s[kt][e] *= (0.044194173824159216f * 1.4426950408889634f); mx = fmaxf(mx, s[kt][e]); }
        mx = fmaxf(mx, __shfl_xor(mx, 16)); mx = fmaxf(mx, __shfl_xor(mx, 32));
        float l = 0.f;
#pragma unroll
        for (int kt = 0; kt < 16; ++kt)
#pragma unroll
            for (int e = 0; e < 4; ++e) { const float p = __builtin_amdgcn_exp2f(s[kt][e] - mx); s[kt][e] = p; l += p; }
        l += __shfl_xor(l, 16); l += __shfl_xor(l, 32);
        const float il = 1.0f / l;
        bf16x8 pf[8];
#pragma unroll
        for (int kc = 0; kc < 8; ++kc) pf[kc] = packP(s[2 * kc], s[2 * kc + 1]);
        for (int c = 8; c < 16; ++c) {
            if (c + 1 < 16) XA_GLOAD(c + 1);
            LAS unsigned char* buf = lds + (c & 1) * KV_TILE;
            f32x4 o[4];
#pragma unroll
            for (int dt = 0; dt < 4; ++dt) o[dt] = (f32x4){0.f, 0.f, 0.f, 0.f};
#pragma unroll
            for (int kc = 0; kc < 8; ++kc) { LAS unsigned char* va = buf + voff + kc * (32 * KV_PB); LAS unsigned char* vb = va + 16 * KV_PB;
#pragma unroll
                for (int dt = 0; dt < 4; ++dt) { const v4s lo = tr_read8(va + dt * 32), hi = tr_read8(vb + dt * 32); o[dt] = MFMA16(join8(lo, hi), pf[kc], o[dt]); } }
            bf16* op = OM + tokq * DM + h * 512 + 64 * (c - 8) + 4 * g;
#pragma unroll
            for (int dt = 0; dt < 4; ++dt) { v2u w; w.x = cvtpk(o[dt][0] * il, o[dt][1] * il); w.y = cvtpk(o[dt][2] * il, o[dt][3] * il); *(v2u*)(op + 16 * dt) = w; }
            if (c + 1 < 16) XA_WRITE(lds + ((c + 1) & 1) * KV_TILE);
            __syncthreads();
        }
    }
#undef XA_GLOAD
#undef XA_WRITE
}

__global__ void __launch_bounds__(NWAVES * 64, 2) mega_fwd(Args args) {
    extern __shared__ __attribute__((aligned(16))) unsigned char lds_raw[];
    LAS unsigned char* lds = (LAS unsigned char*)lds_raw;
    cg::grid_group grid = cg::this_grid();
    const int tid = threadIdx.x, lane = tid & 63, wave = __builtin_amdgcn_readfirstlane(tid >> 6);
    const int G = gridDim.x, bx = blockIdx.x;
    unsigned char* ws = args.ws;
    float* SS = (float*)(ws + WS_CTL);
    float* cosT = (float*)(ws + WS_COS); float* sinT = (float*)(ws + WS_SIN);
    bf16* MK = (bf16*)(ws + WS_MK); bf16* KVM = (bf16*)(ws + WS_KVM);
    bf16* WGU1 = (bf16*)(ws + WS_WGU1); bf16* WD1 = (bf16*)(ws + WS_WD1); bf16* WGU2 = (bf16*)(ws + WS_WGU2); bf16* WD2 = (bf16*)(ws + WS_WD2);
    bf16* WIN = (bf16*)(ws + WS_WIN); bf16* WOUT = (bf16*)(ws + WS_WOUT); bf16* WQ = (bf16*)(ws + WS_WQ); bf16* WKV = (bf16*)(ws + WS_WKV); bf16* WO = (bf16*)(ws + WS_WO);
    bf16* XN = (bf16*)(ws + WS_XN); bf16* MIXED = (bf16*)(ws + WS_MIXED); bf16* HB = (bf16*)(ws + WS_ACT);
    bf16* Qb = (bf16*)(ws + WS_Q); bf16* Kb = (bf16*)(ws + WS_K); bf16* Vb = (bf16*)(ws + WS_V); bf16* Ub = (bf16*)(ws + WS_U); bf16* GVb = (bf16*)(ws + WS_GV);
    bf16* OBb = (bf16*)(ws + WS_OB); float* LSEb = (float*)(ws + WS_LSE);
    bf16* QM = (bf16*)(ws + WS_QM); bf16* OM = (bf16*)(ws + WS_OM);
    const float* x = (const float*)args.in[0]; const float* mem = (const float*)args.in[1]; const int* positions = (const int*)args.in[2];
    float* HRES = args.out;
    const int lo = args.ph_lo, hi = args.ph_hi;
#ifndef PMASK
#define PMASK 0xFFFF
#endif
#define IN(k) (lo <= (k) && (k) < hi && ((PMASK >> (k)) & 1))
#ifdef PROBE_LO
#define STAMP(k) do { if (bx == 0 && tid == 0) ((unsigned long long*)(ws + WS_CTL + 512 * 1024))[(k) + 1] = __builtin_amdgcn_s_memrealtime(); } while (0)
#else
#define STAMP(k) do { } while (0)
#endif
#define SEAM(k) do { if ((k) == 0) { grid.sync(); xbar = xcd_barrier_post(barw, MISC); } else { xcd_barrier(xbar); } STAMP(k); } while (0)
    unsigned* barw = (unsigned*)(ws + WS_CTL + 768 * 1024);
    volatile LAS unsigned* MISC = (volatile LAS unsigned*)(lds + LDS_BYTES - 64);
    if (tid < 2) MISC[tid] = 0u;
    __syncthreads();
    XcdBarrier xbar; xbar.bar = barw; xbar.x = 0; xbar.st = MISC;
    const int gw = bx * NWAVES + wave, NGW = G * NWAVES;
    const int gt = bx * (NWAVES * 64) + tid, NGT = G * NWAVES * 64;

    STAMP(-1);
    if (IN(0)) {
        LAS float* scr = (LAS float*)(lds + wave * 17408);
#define INF(k) ((const float*)args.in[k])
        constexpr int I_GU = (DM / 64) * (DFF / 64), I_D = (DFF / 64) * (DM / 64), I_IN = (DM / 64) * (DIN / 64), I_SQ = (DM / 64) * (DM / 64);
        constexpr int NITEMS = 2 * (2 * I_GU + I_D) + I_IN + 5 * I_SQ;
        for (int it = gw; it < NITEMS; it += NGW) {
            int r = it;
            if (r < I_GU) { tr_job(INF(4), DM, DFF, INF(3), nullptr, WGU1, 0, 1, r, scr, lane); continue; } r -= I_GU;
            if (r < I_GU) { tr_job(INF(5), DM, DFF, INF(3), nullptr, WGU1, 0, 2, r, scr, lane); continue; } r -= I_GU;
            if (r < I_D) { tr_job(INF(6), DFF, DM, nullptr, nullptr, WD1, 0, 0, r, scr, lane); continue; } r -= I_D;
            if (r < I_GU) { tr_job(INF(23), DM, DFF, INF(22), nullptr, WGU2, 0, 1, r, scr, lane); continue; } r -= I_GU;
            if (r < I_GU) { tr_job(INF(24), DM, DFF, INF(22), nullptr, WGU2, 0, 2, r, scr, lane); continue; } r -= I_GU;
            if (r < I_D) { tr_job(INF(25), DFF, DM, nullptr, nullptr, WD2, 0, 0, r, scr, lane); continue; } r -= I_D;
            if (r < I_IN) { tr_job(INF(8), DM, DIN, INF(7), nullptr, WIN, 0, 3, r, scr, lane); continue; } r -= I_IN;
            if (r < I_SQ) { tr_job(INF(15), DM, DM, INF(13), INF(14), WOUT, 0, 0, r, scr, lane); continue; } r -= I_SQ;
            if (r < I_SQ) { tr_job(INF(18), DM, DM, INF(16), nullptr, WQ, 0, 0, r, scr, lane); continue; } r -= I_SQ;
            if (r < I_SQ) { tr_job(INF(19), DM, DM, nullptr, nullptr, WKV, 0, 0, r, scr, lane); continue; } r -= I_SQ;
            if (r < I_SQ) { tr_job(INF(20), DM, DM, nullptr, nullptr, WKV, 2048, 0, r, scr, lane); continue; } r -= I_SQ;
            tr_job(INF(21), DM, DM, nullptr, nullptr, WO, 0, 0, r, scr, lane);
        }
        for (int m = gw; m < S_; m += NGW) {
            const f32x4* xr = (const f32x4*)(x + (size_t)m * DM) + lane; float s = 0.f; v2u* o8 = (v2u*)(XN + (size_t)m * DM) + lane;
#pragma unroll
            for (int j = 0; j < 8; ++j) { const f32x4 v = xr[64 * j]; s += (v[0] * v[0] + v[1] * v[1]) + (v[2] * v[2] + v[3] * v[3]); v2u w; w.x = pk2(v[0], v[1]); w.y = pk2(v[2], v[3]); o8[64 * j] = w; }
            s = wave_sum(s); if (lane == 0) SS[SS_X * S_ + m] = s;
        }
        for (int m = gw; m < NMEM; m += NGW) {
            const f32x4* xr = (const f32x4*)(mem + (size_t)m * DM) + lane; const f32x4* gr = (const f32x4*)(INF(17)) + lane; float s = 0.f; f32x4 v[8];
#pragma unroll
            for (int j = 0; j < 8; ++j) { v[j] = xr[64 * j]; s += (v[j][0] * v[j][0] + v[j][1] * v[j][1]) + (v[j][2] * v[j][2] + v[j][3] * v[j][3]); }
            const float rs = 1.0f / sqrtf(wave_sum(s) * (1.0f / DM) + 1e-6f); v2u* o8 = (v2u*)(MK + (size_t)m * DM) + lane;
#pragma unroll
            for (int j = 0; j < 8; ++j) { const f32x4 g = gr[64 * j]; v2u w; w.x = pk2(v[j][0] * rs * g[0], v[j][1] * rs * g[1]); w.y = pk2(v[j][2] * rs * g[2], v[j][3] * rs * g[3]); o8[64 * j] = w; }
        }
        if (bx == 0) for (int i = tid; i < XCD_BAR_WORDS; i += NWAVES * 64) barw[i] = 0u;
        for (int i = gt; i < (SS_N - 1) * S_; i += NGT) SS[S_ + i] = 0.f;
        for (int i = gt; i < S_ * 32; i += NGT) {
            const int row = i >> 5, dd = i & 31; const double xx = (double)positions[row] * INVF[dd];
            const double kq = __builtin_rint(xx * 0.6366197723675814);
            double rr = __builtin_fma(-kq, 1.5707963267948966, xx); rr = __builtin_fma(-kq, 6.123233995736766e-17, rr);
            const int q = ((int)kq) & 3; const double r2 = rr * rr;
            double sn = -1.0 / 1307674368000.0; sn = sn * r2 + 1.0 / 6227020800.0; sn = sn * r2 - 1.0 / 39916800.0; sn = sn * r2 + 1.0 / 362880.0; sn = sn * r2 - 1.0 / 5040.0; sn = sn * r2 + 1.0 / 120.0; sn = sn * r2 - 1.0 / 6.0; sn = sn * r2 + 1.0; sn *= rr;
            double cs = 1.0 / 20922789888000.0; cs = cs * r2 - 1.0 / 87178291200.0; cs = cs * r2 + 1.0 / 479001600.0; cs = cs * r2 - 1.0 / 3628800.0; cs = cs * r2 + 1.0 / 40320.0; cs = cs * r2 - 1.0 / 720.0; cs = cs * r2 + 1.0 / 24.0; cs = cs * r2 - 0.5; cs = cs * r2 + 1.0;
            const double sv = (q == 0) ? sn : (q == 1) ? cs : (q == 2) ? -sn : -cs;
            const double cv = (q == 0) ? cs : (q == 1) ? -sn : (q == 2) ? -cs : sn;
            cosT[i] = (float)cv; sinT[i] = (float)sv;
        }
    }
    SEAM(0);

    if (IN(1)) {
        pg8::Gemm g{XN, WGU1, S_, 2 * DFF, DM}; pg8::StaticOrder S; S.init(S_, 2 * DFF, G, bx);
        pg8::EpiSwiglu E{HB, DFF, SS + SS_X * S_, 1.0f / DM};
        pg8::gemm_phase<pg8::EpiSwiglu, pg8::StaticOrder, true, true>(lds, g, S, E);
    }
    SEAM(1);
    if (IN(2)) {
        pg8::Gemm g{HB, WD1, S_, DM, DFF}; pg8::StaticOrder S; S.init(S_, DM, G, bx);
        pg8::EpiResid<false> E{x, HRES, XN, SS + SS_H1 * S_, nullptr, 0.f, 0.5f, nullptr};
        pg8::gemm_phase<pg8::EpiResid<false>, pg8::StaticOrder, true, true>(lds, g, S, E);
    }
    SEAM(2);
    if (IN(3)) {
        { pg8::Gemm g{XN, WIN, S_, DIN, DM}; pg8::StaticOrder S; S.init(S_, DIN, G, bx);
          pg8::EpiWin E{Qb, (size_t)(8u << 20), SS + SS_H1 * S_, 1.0f / DM, cosT, sinT, SS + LN_S1 * S_, SS + LN_S2 * S_};
          pg8::gemm_phase<pg8::EpiWin, pg8::StaticOrder, true, true>(lds, g, S, E); }
        { pg8::Gemm g{MK, WKV, NMEM, 2 * DM, DM}; pg8::StaticOrder S; S.init(NMEM, 2 * DM, G, (bx + G / 2) % G);
          pg8::EpiBf16Scale E{KVM, 2 * DM, nullptr, 0.f};
          pg8::gemm_phase<pg8::EpiBf16Scale, pg8::StaticOrder, true, true>(lds, g, S, E); }
    }
    SEAM(3);
    if (IN(4)) {
#if USE_MFMA_ATTN
        dattn_mfma(lds, Qb, Kb, Vb, OBb, LSEb, bx, G, tid, wave, lane);
#else
        attn_naive(lds, Qb, Kb, Vb, MIXED, SS + SS_A * S_, gw, NGW, wave, lane);
        __syncthreads();
#endif
#if USE_MFMA_SGU
        sgu_mfma(lds, Ub, GVb, SS + LN_S1 * S_, SS + LN_S2 * S_, (const float*)args.in[9], (const float*)args.in[10], (const float*)args.in[11], (const float*)args.in[12], MIXED, SS + SS_S * S_, bx, G, tid, wave, lane);
#else
        sgu_naive(lds, Ub, GVb, SS + LN_S1 * S_, SS + LN_S2 * S_, (const float*)args.in[9], (const float*)args.in[10], (const float*)args.in[11], (const float*)args.in[12], MIXED, SS + SS_S * S_, bx, G, tid, lane);
#endif
    }
    SEAM(4);
    if (IN(5)) {
        for (int m = gw; m < S_; m += NGW) {
            const float rsg = 1.0f / sqrtf(SS[SS_S * S_ + m] * (1.0f / AW) + 1e-6f);
            v4u* p = (v4u*)(MIXED + (size_t)m * DM) + lane;
#if USE_MFMA_ATTN
            float val[2][8]; float ssq = 0.f;
#pragma unroll
            for (int j = 0; j < 2; ++j) { const int c = lane + 64 * j, hh = c >> 3;
                const float l0 = LSEb[((size_t)0 * S_ + m) * 16 + hh], l1 = LSEb[((size_t)1 * S_ + m) * 16 + hh], l2 = LSEb[((size_t)2 * S_ + m) * 16 + hh];
                const float mx = fmaxf(l0, fmaxf(l1, l2)); float w0 = __builtin_amdgcn_exp2f(l0 - mx), w1 = __builtin_amdgcn_exp2f(l1 - mx), w2 = __builtin_amdgcn_exp2f(l2 - mx);
                const float inv = 1.0f / (w0 + w1 + w2); w0 *= inv; w1 *= inv; w2 *= inv;
                const bf16x8 a0 = *(const bf16x8*)(OBb + ((size_t)0 * S_ + m) * AW + 8 * c), a1 = *(const bf16x8*)(OBb + ((size_t)1 * S_ + m) * AW + 8 * c), a2 = *(const bf16x8*)(OBb + ((size_t)2 * S_ + m) * AW + 8 * c);
#pragma unroll
                for (int e = 0; e < 8; ++e) { const float v = w0 * bf2f((unsigned short)a0[e]) + w1 * bf2f((unsigned short)a1[e]) + w2 * bf2f((unsigned short)a2[e]); val[j][e] = v; ssq += v * v; } }
            const float ra = 1.0f / sqrtf(wave_sum(ssq) * (1.0f / AW) + 1e-6f);
#pragma unroll
            for (int j = 0; j < 2; ++j) { v4u w; w.x = pk2(val[j][0] * ra, val[j][1] * ra); w.y = pk2(val[j][2] * ra, val[j][3] * ra); w.z = pk2(val[j][4] * ra, val[j][5] * ra); w.w = pk2(val[j][6] * ra, val[j][7] * ra); p[64 * j] = w; }
#else
            const float ra = 1.0f / sqrtf(SS[SS_A * S_ + m] * (1.0f / AW) + 1e-6f);
#endif
#pragma unroll
            for (int j = (USE_MFMA_ATTN ? 2 : 0); j < 4; ++j) { v4u w = p[64 * j]; const float sc = j < 2 ? ra : rsg;
                w.x = pk2(bf2f((unsigned short)(w.x & 0xffff)) * sc, bf2f((unsigned short)(w.x >> 16)) * sc); w.y = pk2(bf2f((unsigned short)(w.y & 0xffff)) * sc, bf2f((unsigned short)(w.y >> 16)) * sc);
                w.z = pk2(bf2f((unsigned short)(w.z & 0xffff)) * sc, bf2f((unsigned short)(w.z >> 16)) * sc); w.w = pk2(bf2f((unsigned short)(w.w & 0xffff)) * sc, bf2f((unsigned short)(w.w >> 16)) * sc);
                p[64 * j] = w; }
        }
    }
    SEAM(5);
    if (IN(6)) {
        pg8::Gemm g{MIXED, WOUT, S_, DM, DM}; pg8::StaticOrder S; S.init(S_, DM, G, bx);
        pg8::EpiResid<false> E{HRES, HRES, XN, SS + SS_H2 * S_, nullptr, 0.f, 1.0f, nullptr};
        pg8::gemm_phase<pg8::EpiResid<false>, pg8::StaticOrder, true, true>(lds, g, S, E);
    }
    SEAM(6);
    if (IN(7)) {
        pg8::Gemm g{XN, WQ, S_, DM, DM}; pg8::StaticOrder S; S.init(S_, DM, G, bx);
        pg8::EpiBf16Scale E{QM, DM, SS + SS_H2 * S_, 1.0f / DM};
        pg8::gemm_phase<pg8::EpiBf16Scale, pg8::StaticOrder, true, true>(lds, g, S, E);
    }
    SEAM(7);
    if (IN(8)) {
#if USE_MFMA_XATTN
        xattn_mfma(lds, QM, KVM, OM, bx, G, tid, wave, lane);
#else
        xattn_naive(lds, QM, KVM, OM, gw, NGW, wave, lane);
#endif
    }
    SEAM(8);
    if (IN(9)) {
        pg8::Gemm g{OM, WO, S_, DM, DM}; pg8::StaticOrder S; S.init(S_, DM, G, bx);
        pg8::EpiResid<false> E{HRES, HRES, XN, SS + SS_H3 * S_, nullptr, 0.f, 1.0f, nullptr};
        pg8::gemm_phase<pg8::EpiResid<false>, pg8::StaticOrder, true, true>(lds, g, S, E);
    }
    SEAM(9);
    if (IN(10)) {
        pg8::Gemm g{XN, WGU2, S_, 2 * DFF, DM}; pg8::StaticOrder S; S.init(S_, 2 * DFF, G, bx);
        pg8::EpiSwiglu E{HB, DFF, SS + SS_H3 * S_, 1.0f / DM};
        pg8::gemm_phase<pg8::EpiSwiglu, pg8::StaticOrder, true, true>(lds, g, S, E);
    }
    SEAM(10);
    if (IN(11)) {
        pg8::Gemm g{HB, WD2, S_, DM, DFF}; pg8::StaticOrder S; S.init(S_, DM, G, bx);
        pg8::EpiResid<false> E{HRES, HRES, nullptr, SS + SS_H4 * S_, nullptr, 0.f, 0.5f, nullptr};
        pg8::gemm_phase<pg8::EpiResid<false>, pg8::StaticOrder, true, true>(lds, g, S, E);
    }
    SEAM(11);
    if (IN(12)) {
        const float* fg = (const float*)args.in[26];
        for (int m = gw; m < S_; m += NGW) {
            f32x4* xr = (f32x4*)(HRES + (size_t)m * DM) + lane; const f32x4* gr = (const f32x4*)fg + lane;
            const float rs = 1.0f / sqrtf(SS[SS_H4 * S_ + m] * (1.0f / DM) + 1e-6f);
            float pert = 0.f;
#ifdef PROBE_LO
            if (m < 8) { const unsigned long long* ts = (const unsigned long long*)(ws + WS_CTL + 512 * 1024); const float t_us = (float)(ts[PROBE_HI + 1] - ts[PROBE_LO]) * 0.01f; pert = sqrtf(t_us * 1.024e-5f); }
#endif
#pragma unroll
            for (int j = 0; j < 8; ++j) { f32x4 v = xr[64 * j]; const f32x4 g = gr[64 * j]; v = v * rs * g + pert; xr[64 * j] = v; }
        }
    }
#undef IN
#undef SEAM
}

constexpr int NPH = 13;
extern "C" void kernel_launch(void* const* d_in, const int* in_sizes, int n_in, void* d_out, int out_size, void* d_ws, size_t ws_size, hipStream_t stream) {
    static int grid = 0;
    if (grid == 0) {
        if (n_in != 27 || out_size != S_ * DM || ws_size < WS_END) { fprintf(stderr, "kernel_launch: unexpected problem (n_in %d out %d ws %zu)\n", n_in, out_size, ws_size); grid = -1; return; }
        int dev = 0, cus = 0, per_cu = 0;
        hipGetDevice(&dev); hipDeviceGetAttribute(&cus, hipDeviceAttributeMultiprocessorCount, dev);
        hipFuncSetAttribute((const void*)mega_fwd, hipFuncAttributeMaxDynamicSharedMemorySize, LDS_BYTES);
        hipOccupancyMaxActiveBlocksPerMultiprocessor(&per_cu, (const void*)mega_fwd, NWAVES * 64, LDS_BYTES);
        if (per_cu < 1) per_cu = 1;
        (void)hipGetLastError();
        grid = cus * 1;
        fprintf(stderr, "kernel_launch: cus %d per_cu %d grid %d\n", cus, per_cu, grid);
    }
    if (grid < 0) return;
    Args a{};
    for (int i = 0; i < 27; ++i) a.in[i] = d_in[i];
    a.out = (float*)d_out; a.ws = (unsigned char*)d_ws; a.ph_lo = 0; a.ph_hi = NPH;
    void* kargs[] = {&a};
    hipError_t e = hipLaunchCooperativeKernel((const void*)mega_fwd, dim3(grid), dim3(NWAVES * 64), kargs, LDS_BYTES, stream);
    if (e != hipSuccess) fprintf(stderr, "cooperative launch failed: %s (grid %d)\n", hipGetErrorString(e), grid);
}
```

```cpp
#include <hip/hip_runtime.h>
#include <hip/hip_cooperative_groups.h>
#include <cstdio>
#include <cstdint>
#include <cmath>
namespace cg = cooperative_groups;
namespace pg8 {
#define PG8_LAS __attribute__((address_space(3)))
typedef unsigned short bf16_t;
typedef short bf16x8 __attribute__((ext_vector_type(8)));
typedef float f32x4 __attribute__((ext_vector_type(4)));
typedef unsigned u32x4 __attribute__((ext_vector_type(4)));
constexpr int BM = 256, BK = 64, HALF = 128, HTB = HALF * BK * 2  , STAGE_BYTES = 8 * HTB, NXCD = 8, WGM = 8;

__host__ __device__ __forceinline__ int lds_byte(int r, int c) { const int st = (r >> 4) * 2 + (c >> 5), rr = r & 15, cc = c & 31, ob = rr * 64 + cc * 2; return st * 1024 + (ob ^ (((ob >> 9) & 1) << 5)); }
__host__ __device__ __forceinline__ void stage_rc(int b, int& R, int& C) { const int st = b / 1024, sb = b % 1024, swz = sb ^ (((sb >> 9) & 1) << 5); R = (st >> 1) * 16 + swz / 64; C = (st & 1) * 32 + (swz % 64) / 2; }
__host__ __device__ __forceinline__ int perm32(int rho) { const int n = rho >> 4, i = rho & 15; return 8 * (i >> 2) + 4 * n + (i & 3); }

struct Unit { int pm, pn; };
struct Gemm { const bf16_t* A; const bf16_t* Bt; int M, N, K; };

struct StaticOrder {
    int nM, nN, nwg, G, c;
    __host__ __device__ void init(int M, int N, int G_, int c_) { nM = M / BM; nN = N / BM; nwg = nM * nN; G = G_; c = c_; }
    __host__ __device__ bool next(int i, Unit& u) const {
        const long L = (long)i * G + c; if (L >= nwg) return false;
        int wgid = (int)L; { const int q = nwg / NXCD, r = nwg % NXCD, xcd = wgid % NXCD, off = wgid / NXCD; wgid = (xcd < r ? xcd * (q + 1) : r * (q + 1) + (xcd - r) * q) + off; }
        const int nig = WGM * nN, gid = wgid / nig, fm = gid * WGM, gsz = (nM - fm) < WGM ? (nM - fm) : WGM;
        u.pm = fm + ((wgid % nig) % gsz); u.pn = (wgid % nig) / gsz; return true;
    }
    __device__ __forceinline__ void a_ready(const Unit&) const {}
    __device__ __forceinline__ void done(const Unit&) const {}
};

__device__ __forceinline__ unsigned cvt_pk_bf16(float lo, float hi) { unsigned r; asm volatile("v_cvt_pk_bf16_f32 %0, %1, %2" : "=v"(r) : "v"(lo), "v"(hi)); return r; }
typedef float f32x2 __attribute__((ext_vector_type(2)));
constexpr float NEPS = 1e-6f;
__device__ __forceinline__ float fast_sigmoid(float z) { return __builtin_amdgcn_rcpf(1.0f + __builtin_amdgcn_exp2f(-1.4426950408889634f * z)); }
__device__ __forceinline__ float silu_f(float x) { return x * fast_sigmoid(x); }
__device__ __forceinline__ float gelu_tanh_f(float x) { const float z = 1.5957691216057308f * (x + 0.044715f * x * x * x); return x * fast_sigmoid(z); }
__device__ __forceinline__ u32x4 pack8(const f32x4 a, const f32x4 b) { u32x4 w; w.x = cvt_pk_bf16(a[0], a[1]); w.y = cvt_pk_bf16(a[2], a[3]); w.z = cvt_pk_bf16(b[0], b[1]); w.w = cvt_pk_bf16(b[2], b[3]); return w; }

struct EpiSwiglu {
    static constexpr bool PERM = true, AFTER_DRAIN = false, MID = false;
    bf16_t* H; int ldh; const float* ss; float invw;
    __device__ __forceinline__ void operator()(const f32x4 (&acc)[2][2][4][2], const Unit& u, int wr, int wc, int fr, int fq) const {
        const int row0 = u.pm * BM + wr * 64 + fr, col0 = u.pn * HALF + wc * 32 + 8 * fq;
        float rsv[2][4];
#pragma unroll
        for (int ai = 0; ai < 2; ++ai)
#pragma unroll
            for (int m = 0; m < 4; ++m) rsv[ai][m] = ss[row0 + ai * HALF + m * 16];
#pragma unroll
        for (int ai = 0; ai < 2; ++ai)
#pragma unroll
            for (int m = 0; m < 4; ++m) { const int r = row0 + ai * HALF + m * 16; const float rs = __builtin_amdgcn_rsqf(rsv[ai][m] * invw + NEPS);
                f32x4 h0, h1;
#pragma unroll
                for (int j = 0; j < 4; ++j) { h0[j] = silu_f(acc[ai][0][m][0][j] * rs) * (acc[ai][1][m][0][j] * rs); h1[j] = silu_f(acc[ai][0][m][1][j] * rs) * (acc[ai][1][m][1][j] * rs); }
                *(u32x4*)(H + (size_t)r * ldh + col0) = pack8(h0, h1); }
    }
};

template <bool HAS_MID> struct EpiResid {
    static constexpr bool PERM = true, AFTER_DRAIN = false, MID = HAS_MID;
    const float* base; float* out; bf16_t* xn; float* ss_out; const float* ss_in; float invw_in; float alpha; const float* ss_mid;
    __device__ __forceinline__ void mid(f32x4 (&acc)[2][2][4][2], const Unit& u, int wr, int fr) const {
        const int row0 = u.pm * BM + wr * 64 + fr;
#pragma unroll
        for (int ai = 0; ai < 2; ++ai)
#pragma unroll
            for (int m = 0; m < 4; ++m) { const int r = row0 + ai * HALF + m * 16;
                const float ratio = __builtin_amdgcn_rsqf(ss_mid[r] * invw_in + NEPS) * __builtin_sqrtf(ss_in[r] * invw_in + NEPS);
#pragma unroll
                for (int bj = 0; bj < 2; ++bj)
#pragma unroll
                    for (int n = 0; n < 2; ++n) acc[ai][bj][m][n] = acc[ai][bj][m][n] * ratio; }
    }
    __device__ __forceinline__ void operator()(const f32x4 (&acc)[2][2][4][2], const Unit& u, int wr, int wc, int fr, int fq) const {
        const int row0 = u.pm * BM + wr * 64 + fr, col0 = u.pn * BM + wc * 32 + 8 * fq;
        const float sc = alpha;
#pragma unroll
        for (int ai = 0; ai < 2; ++ai) {
            f32x4 bb[4][2][2];
#pragma unroll
            for (int m = 0; m < 4; ++m)
#pragma unroll
                for (int bj = 0; bj < 2; ++bj) { const size_t off = (size_t)(row0 + ai * HALF + m * 16) * 2048 + col0 + bj * HALF; bb[m][bj][0] = *(const f32x4*)(base + off); bb[m][bj][1] = *(const f32x4*)(base + off + 4); }
#pragma unroll
            for (int m = 0; m < 4; ++m) { const int r = row0 + ai * HALF + m * 16; float q = 0.f;
#pragma unroll
                for (int bj = 0; bj < 2; ++bj) { const size_t off = (size_t)r * 2048 + col0 + bj * HALF;
                    const f32x4 o0 = bb[m][bj][0] + acc[ai][bj][m][0] * sc, o1 = bb[m][bj][1] + acc[ai][bj][m][1] * sc;
                    *(f32x4*)(out + off) = o0; *(f32x4*)(out + off + 4) = o1;
                    q += (o0[0] * o0[0] + o0[1] * o0[1]) + (o0[2] * o0[2] + o0[3] * o0[3]) + (o1[0] * o1[0] + o1[1] * o1[1]) + (o1[2] * o1[2] + o1[3] * o1[3]);
                    if (xn) *(u32x4*)(xn + off) = pack8(o0, o1); }
                q += __shfl_xor(q, 16); q += __shfl_xor(q, 32);
                if (fq == 0) atomicAdd(ss_out + r, q); }
        }
    }
};

struct EpiBf16Scale {
    static constexpr bool PERM = true, AFTER_DRAIN = false, MID = false;
    bf16_t* O; int ldc; const float* ss; float invw;
    __device__ __forceinline__ void operator()(const f32x4 (&acc)[2][2][4][2], const Unit& u, int wr, int wc, int fr, int fq) const {
        const int row0 = u.pm * BM + wr * 64 + fr, col0 = u.pn * BM + wc * 32 + 8 * fq;
        float rsv[2][4];
#pragma unroll
        for (int ai = 0; ai < 2; ++ai)
#pragma unroll
            for (int m = 0; m < 4; ++m) rsv[ai][m] = ss ? ss[row0 + ai * HALF + m * 16] : 1.0f;
#pragma unroll
        for (int ai = 0; ai < 2; ++ai)
#pragma unroll
            for (int m = 0; m < 4; ++m) { const int r = row0 + ai * HALF + m * 16; const float rs = ss ? __builtin_amdgcn_rsqf(rsv[ai][m] * invw + NEPS) : 1.0f;
#pragma unroll
                for (int bj = 0; bj < 2; ++bj) *(u32x4*)(O + (size_t)r * ldc + col0 + bj * HALF) = pack8(acc[ai][bj][m][0] * rs, acc[ai][bj][m][1] * rs); }
    }
};

struct EpiWin {
    static constexpr bool PERM = true, AFTER_DRAIN = false, MID = false;
    bf16_t* QKVUG; size_t rstride; const float* ss; float invw; const float* cosT; const float* sinT; float* ln_s1; float* ln_s2;
    __device__ __forceinline__ void operator()(const f32x4 (&acc)[2][2][4][2], const Unit& u, int wr, int wc, int fr, int fq) const {
        const int reg = u.pn >> 2, cc = (u.pn & 3) * BM, row0 = u.pm * BM + wr * 64 + fr;
        float rsv[2][4];
#pragma unroll
        for (int ai = 0; ai < 2; ++ai)
#pragma unroll
            for (int m = 0; m < 4; ++m) rsv[ai][m] = ss[row0 + ai * HALF + m * 16];
        if (reg < 2) {
            bf16_t* O = QKVUG + (size_t)reg * rstride;
#pragma unroll
            for (int aim = 0; aim < 4; ++aim) { const int ai = aim >> 1;
                f32x4 cs[2][4];
#pragma unroll
                for (int mm = 0; mm < 2; ++mm) { const size_t ro = (size_t)(row0 + ai * HALF + ((aim & 1) * 2 + mm) * 16) * 32 + 8 * fq;
                    cs[mm][0] = *(const f32x4*)(cosT + ro); cs[mm][1] = *(const f32x4*)(cosT + ro + 4); cs[mm][2] = *(const f32x4*)(sinT + ro); cs[mm][3] = *(const f32x4*)(sinT + ro + 4); }
#pragma unroll
                for (int mm = 0; mm < 2; ++mm) { const int m = (aim & 1) * 2 + mm; const int r = row0 + ai * HALF + m * 16; const float rs = __builtin_amdgcn_rsqf(rsv[ai][m] * invw + NEPS);
                    const f32x4 c0 = cs[mm][0], c1 = cs[mm][1], s0 = cs[mm][2], s1 = cs[mm][3];
                    const f32x4 a0 = acc[ai][0][m][0] * rs, a1 = acc[ai][0][m][1] * rs, b0 = acc[ai][1][m][0] * rs, b1 = acc[ai][1][m][1] * rs;
                    const f32x4 lo0 = a0 * c0 - b0 * s0, lo1 = a1 * c1 - b1 * s1, hi0 = a0 * s0 + b0 * c0, hi1 = a1 * s1 + b1 * c1;
                    bf16_t* p = O + (size_t)r * 1024 + cc + 64 * wc + 8 * fq;
                    *(u32x4*)p = pack8(lo0, lo1); *(u32x4*)(p + 32) = pack8(hi0, hi1); }
            }
        } else {
            bf16_t* O = QKVUG + (size_t)reg * rstride;
#pragma unroll
            for (int ai = 0; ai < 2; ++ai)
#pragma unroll
                for (int m = 0; m < 4; ++m) { const int r = row0 + ai * HALF + m * 16; const float rs = __builtin_amdgcn_rsqf(rsv[ai][m] * invw + NEPS);
                    float s1 = 0.f, s2 = 0.f;
#pragma unroll
                    for (int bj = 0; bj < 2; ++bj) { f32x4 v0 = acc[ai][bj][m][0] * rs, v1 = acc[ai][bj][m][1] * rs;
                        if (reg >= 3) {
#pragma unroll
                            for (int j = 0; j < 4; ++j) { v0[j] = gelu_tanh_f(v0[j]); v1[j] = gelu_tanh_f(v1[j]); } }
                        if (reg == 4) { s1 += (v0[0] + v0[1]) + (v0[2] + v0[3]) + (v1[0] + v1[1]) + (v1[2] + v1[3]);
                            s2 += (v0[0] * v0[0] + v0[1] * v0[1]) + (v0[2] * v0[2] + v0[3] * v0[3]) + (v1[0] * v1[0] + v1[1] * v1[1]) + (v1[2] * v1[2] + v1[3] * v1[3]); }
                        *(u32x4*)(O + (size_t)r * 1024 + cc + bj * HALF + 32 * wc + 8 * fq) = pack8(v0, v1); }
                    if (reg == 4) { s1 += __shfl_xor(s1, 16); s1 += __shfl_xor(s1, 32); s2 += __shfl_xor(s2, 16); s2 += __shfl_xor(s2, 32);
                        if (fq == 0) { atomicAdd(ln_s1 + r, s1); atomicAdd(ln_s2 + r, s2); } } }
        }
    }
};
template <class Epi, class Sched, bool ALIGN_EPI = false, bool SP2 = false>
__device__ __forceinline__ void gemm_phase(PG8_LAS unsigned char* lds, const Gemm g, const Sched& S, const Epi& E) {
    const int tid = threadIdx.x, wid = __builtin_amdgcn_readfirstlane(tid >> 6), lane = tid & 63, wr = wid >> 2, wc = wid & 3, fr = lane & 15, fq = lane >> 4;
    const int K = g.K, nt = K / BK;
    unsigned voffA[2], voffB[2];
#pragma unroll
    for (int i = 0; i < 2; ++i) { int R, C; stage_rc(tid * 16 + i * 8192, R, C); const int Rb = Epi::PERM ? ((R & ~31) + perm32(R & 31)) : R;
        voffA[i] = (unsigned)(R * K + C) * 2u; voffB[i] = (unsigned)(Rb * K + C) * 2u; }
    const size_t kstep = (size_t)(BK * 2);
    const size_t hstep = (size_t)HALF * K * 2;
    const size_t tstep = 2 * hstep;
    const unsigned ldsw = (unsigned)wid * 1024u;
    const int aoff = lds_byte(wr * 64 + fr, fq * 8), boff = lds_byte(wc * 32 + fr, fq * 8);
#define PG8_SA(b, h) (((b) * 2 + (h)) * HTB)
#define PG8_SB(b, h) ((4 + (b) * 2 + (h)) * HTB)
#define PG8_STAGE(bufoff, gbase, voff) do { _Pragma("unroll") for (int _i = 0; _i < 2; ++_i) \
        __builtin_amdgcn_global_load_lds((const unsigned*)((const char*)(gbase) + (voff)[_i]), (PG8_LAS unsigned*)(lds + (bufoff) + ldsw + _i * 8192), 16, 0, 0); } while (0)
#define PG8_LDA(dst, b, h) do { _Pragma("unroll") for (int m = 0; m < 4; ++m) _Pragma("unroll") for (int k = 0; k < 2; ++k) dst[m][k] = *(const PG8_LAS bf16x8*)(lds + PG8_SA(b, h) + aoff + m * 2048 + k * 1024); } while (0)
#define PG8_LDB(dst, b, h) do { _Pragma("unroll") for (int n = 0; n < 2; ++n) _Pragma("unroll") for (int k = 0; k < 2; ++k) dst[n][k] = *(const PG8_LAS bf16x8*)(lds + PG8_SB(b, h) + boff + n * 2048 + k * 1024); } while (0)
#define PG8_MMA(ai, bj, At, Bt) do { __builtin_amdgcn_s_setprio(1); _Pragma("unroll") for (int m = 0; m < 4; ++m) _Pragma("unroll") for (int n = 0; n < 2; ++n) _Pragma("unroll") for (int k = 0; k < 2; ++k) \
        acc[ai][bj][m][n] = __builtin_amdgcn_mfma_f32_16x16x32_bf16(Bt[n][k], At[m][k], acc[ai][bj][m][n], 0, 0, 0); __builtin_amdgcn_s_setprio(0); } while (0)
#define PG8_WAIT_V(n) asm volatile("s_waitcnt vmcnt(" #n ")" ::: "memory")
#define PG8_WAIT_L(n) asm volatile("s_waitcnt lgkmcnt(" #n ")" ::: "memory")
#define PG8_BAR __builtin_amdgcn_s_barrier()
#define PG8_SCHED __builtin_amdgcn_sched_barrier(0)
    Unit cur, nxt; int ui = 0;
    if (!S.next(0, cur)) return;
    f32x4 acc[2][2][4][2];
#pragma unroll
    for (int a = 0; a < 2; ++a)
#pragma unroll
        for (int b = 0; b < 2; ++b)
#pragma unroll
            for (int m = 0; m < 4; ++m)
#pragma unroll
                for (int n = 0; n < 2; ++n) acc[a][b][m][n] = (f32x4){0.f, 0.f, 0.f, 0.f};
    bf16x8 At[4][2], B0[2][2], B1[2][2];
    const char* cA = (const char*)g.A + (size_t)cur.pm * tstep; const char* cB = (const char*)g.Bt + (size_t)cur.pn * tstep;
    S.a_ready(cur);
    if constexpr (SP2) {
        PG8_STAGE(PG8_SB(0, 0), cB, voffB); PG8_STAGE(PG8_SB(0, 1), cB + hstep, voffB); PG8_STAGE(PG8_SA(0, 0), cA, voffA); PG8_STAGE(PG8_SA(0, 1), cA + hstep, voffA);
        if (wr == 1) PG8_BAR;
        PG8_WAIT_V(2); PG8_BAR;
        PG8_STAGE(PG8_SB(1, 0), cB + kstep, voffB); PG8_STAGE(PG8_SA(1, 0), cA + kstep, voffA); PG8_STAGE(PG8_SB(1, 1), cB + hstep + kstep, voffB);
        PG8_WAIT_V(6); PG8_BAR;
    } else {
        PG8_STAGE(PG8_SB(0, 0), cB, voffB); PG8_STAGE(PG8_SA(0, 0), cA, voffA); PG8_STAGE(PG8_SB(0, 1), cB + hstep, voffB); PG8_STAGE(PG8_SA(0, 1), cA + hstep, voffA);
        if (wr == 1) PG8_BAR;
        PG8_WAIT_V(4); PG8_BAR;
        PG8_STAGE(PG8_SB(1, 0), cB + kstep, voffB); PG8_STAGE(PG8_SA(1, 0), cA + kstep, voffA); PG8_STAGE(PG8_SB(1, 1), cB + hstep + kstep, voffB);
        PG8_WAIT_V(6); PG8_BAR;
    }
    for (;;) {
        const bool has_next = S.next(ui + 1, nxt);
        const char* nA = has_next ? (const char*)g.A + (size_t)nxt.pm * tstep : cA; const char* nB = has_next ? (const char*)g.Bt + (size_t)nxt.pn * tstep : cB;
        for (int t = 0; t < nt; t += 2) {
            if constexpr (Epi::MID) { if (t == (nt >> 1)) E.mid(acc, cur, wr, fr); }
            const bool last = (t == nt - 2);
            const char* a1 = cA + (size_t)(t + 1) * kstep;
            const char* a2 = last ? nA : cA + (size_t)(t + 2) * kstep; const char* b2 = last ? nB : cB + (size_t)(t + 2) * kstep;
            const char* a3 = a2 + kstep; const char* b3 = b2 + kstep;
            if (last && has_next) S.a_ready(nxt);
            if constexpr (SP2) {
            PG8_LDB(B0, 0, 0); PG8_LDB(B1, 0, 1); PG8_SCHED; PG8_LDA(At, 0, 0); PG8_STAGE(PG8_SA(1, 1), a1 + hstep, voffA);
            PG8_WAIT_V(8); PG8_WAIT_L(0); PG8_BAR; PG8_MMA(0, 0, At, B0); PG8_MMA(0, 1, At, B1); PG8_BAR; PG8_SCHED;
            PG8_LDA(At, 0, 1); PG8_STAGE(PG8_SB(0, 0), b2, voffB); PG8_STAGE(PG8_SB(0, 1), b2 + hstep, voffB); PG8_STAGE(PG8_SA(0, 0), a2, voffA);
            PG8_WAIT_V(8); PG8_WAIT_L(0); PG8_BAR; PG8_MMA(1, 0, At, B0); PG8_MMA(1, 1, At, B1); PG8_BAR; PG8_SCHED;
            PG8_LDB(B0, 1, 0); PG8_LDB(B1, 1, 1); PG8_SCHED; PG8_LDA(At, 1, 0); PG8_STAGE(PG8_SA(0, 1), a2 + hstep, voffA);
            PG8_WAIT_V(8); PG8_WAIT_L(0); PG8_BAR; PG8_MMA(0, 0, At, B0); PG8_MMA(0, 1, At, B1); PG8_BAR; PG8_SCHED;
            PG8_LDA(At, 1, 1); PG8_STAGE(PG8_SB(1, 0), b3, voffB); PG8_STAGE(PG8_SB(1, 1), b3 + hstep, voffB); PG8_STAGE(PG8_SA(1, 0), a3, voffA);
            PG8_WAIT_V(8); PG8_WAIT_L(0); PG8_BAR; PG8_MMA(1, 0, At, B0); PG8_MMA(1, 1, At, B1); PG8_BAR; PG8_SCHED;
            } else {
            PG8_LDB(B0, 0, 0); PG8_SCHED; PG8_LDA(At, 0, 0); PG8_STAGE(PG8_SA(1, 1), a1 + hstep, voffA);
            PG8_WAIT_L(8); PG8_BAR; PG8_WAIT_L(0); PG8_MMA(0, 0, At, B0); PG8_BAR; PG8_SCHED;
            PG8_LDB(B1, 0, 1); PG8_STAGE(PG8_SB(0, 0), b2, voffB);
            PG8_BAR; PG8_WAIT_L(0); PG8_MMA(0, 1, At, B1); PG8_BAR;
            PG8_LDA(At, 0, 1); PG8_STAGE(PG8_SA(0, 0), a2, voffA);
            PG8_BAR; PG8_WAIT_L(0); PG8_MMA(1, 0, At, B0); PG8_BAR; PG8_SCHED;
            PG8_STAGE(PG8_SB(0, 1), b2 + hstep, voffB);
            PG8_WAIT_V(6); PG8_BAR; PG8_MMA(1, 1, At, B1); PG8_BAR;
            PG8_LDB(B0, 1, 0); PG8_SCHED; PG8_LDA(At, 1, 0); PG8_STAGE(PG8_SA(0, 1), a2 + hstep, voffA);
            PG8_WAIT_L(8); PG8_BAR; PG8_WAIT_L(0); PG8_MMA(0, 0, At, B0); PG8_BAR; PG8_SCHED;
            PG8_LDB(B1, 1, 1); PG8_STAGE(PG8_SB(1, 0), b3, voffB);
            PG8_BAR; PG8_WAIT_L(0); PG8_MMA(0, 1, At, B1); PG8_BAR;
            PG8_LDA(At, 1, 1); PG8_STAGE(PG8_SA(1, 0), a3, voffA);
            PG8_BAR; PG8_WAIT_L(0); PG8_MMA(1, 0, At, B0); PG8_BAR; PG8_SCHED;
            PG8_STAGE(PG8_SB(1, 1), b3 + hstep, voffB);
            PG8_WAIT_V(6); PG8_BAR; PG8_MMA(1, 1, At, B1); PG8_BAR;
            }
        }
        if constexpr (ALIGN_EPI) { if (wr == 0) PG8_BAR; }
        if constexpr (!Epi::AFTER_DRAIN) { E(acc, cur, wr, wc, fr, fq); S.done(cur); }
        if (!has_next) break;
#pragma unroll
        for (int a = 0; a < 2; ++a)
#pragma unroll
            for (int b = 0; b < 2; ++b)
#pragma unroll
                for (int m = 0; m < 4; ++m)
#pragma unroll
                    for (int n = 0; n < 2; ++n) acc[a][b][m][n] = (f32x4){0.f, 0.f, 0.f, 0.f};
        cur = nxt; cA = nA; cB = nB; ++ui;
        if constexpr (ALIGN_EPI) { if (wr == 1) PG8_BAR; }
    }
    PG8_WAIT_V(0);
    if constexpr (!ALIGN_EPI) { if (wr == 0) PG8_BAR; }
    PG8_BAR;
    if constexpr (Epi::AFTER_DRAIN) { E.fused(acc, cur, wr, wc, fr, fq, lds, wid, lane); S.done(cur); }
#undef PG8_SA
#undef PG8_SB
#undef PG8_STAGE
#undef PG8_LDA
#undef PG8_LDB
#undef PG8_MMA
#undef PG8_WAIT_V
#undef PG8_WAIT_L
#undef PG8_BAR
#undef PG8_SCHED
}
}

constexpr int NWAVES = 8;
constexpr int S_ = 8192, DM = 2048, DFF = 5632, NMEM = 256, DIN = 5120, AW = 1024;
constexpr size_t MiB = 1u << 20;
constexpr size_t WS_CTL = 0, WS_COS = 1 * MiB, WS_SIN = 2 * MiB, WS_MK = 3 * MiB, WS_KVM = 4 * MiB;
constexpr size_t WS_WGU1 = 6 * MiB, WS_WD1 = 50 * MiB, WS_WGU2 = 72 * MiB, WS_WD2 = 116 * MiB, WS_WIN = 138 * MiB, WS_WOUT = 158 * MiB, WS_WQ = 166 * MiB, WS_WKV = 174 * MiB, WS_WO = 190 * MiB;
constexpr size_t WS_XN = 198 * MiB, WS_MIXED = 230 * MiB, WS_OB = 262 * MiB, WS_LSE = 310 * MiB, WS_ACT = 312 * MiB, WS_END = 400 * MiB;
constexpr size_t WS_Q = WS_ACT, WS_K = WS_ACT + 16 * MiB, WS_V = WS_ACT + 32 * MiB, WS_U = WS_ACT + 48 * MiB, WS_GV = WS_ACT + 64 * MiB;
constexpr size_t WS_QM = WS_ACT, WS_OM = WS_ACT + 32 * MiB;
enum { SS_X = 0, SS_H1, LN_S1, LN_S2, SS_A, SS_S, SS_H2, SS_H3, SS_H4, SS_N };
#ifndef USE_MFMA_ATTN
#define USE_MFMA_ATTN 1
#endif
#ifndef USE_MFMA_SGU
#define USE_MFMA_SGU 1
#endif
#ifndef USE_MFMA_XATTN
#define USE_MFMA_XATTN 1
#endif
#ifndef MEMSET_INIT
#define MEMSET_INIT 0
#endif
constexpr int RING_BYTES = 131072, LDS_BYTES = 147456;

#define LAS __attribute__((address_space(3)))
typedef unsigned short bf16;
typedef unsigned v4u __attribute__((ext_vector_type(4)));
typedef unsigned v2u __attribute__((ext_vector_type(2)));
typedef float f32x4 __attribute__((ext_vector_type(4)));
typedef short bf16x8 __attribute__((ext_vector_type(8)));
#define LDS_WAIT() asm volatile("s_waitcnt lgkmcnt(0)" ::: "memory")
__device__ __forceinline__ unsigned f2bf(float f) { unsigned u = __builtin_bit_cast(unsigned, f); return (u + 0x7fffu + ((u >> 16) & 1u)) >> 16; }
__device__ __forceinline__ unsigned pk2(float lo, float hi) { return f2bf(lo) | (f2bf(hi) << 16); }
__device__ __forceinline__ float bf2f(unsigned short b) { return __uint_as_float((unsigned)b << 16); }
__device__ __forceinline__ float wave_sum(float v) {
#pragma unroll
    for (int o = 1; o < 64; o <<= 1) v += __shfl_xor(v, o);
    return v;
}
__device__ __forceinline__ float wave_max(float v) {
#pragma unroll
    for (int o = 1; o < 64; o <<= 1) v = fmaxf(v, __shfl_xor(v, o));
    return v;
}

__constant__ double INVF[32] = {1.0, 0.7498942093324559, 0.5623413251903491, 0.4216965034285822, 0.31622776601683794, 0.23713737056616552, 0.1778279410038923, 0.1333521432163324, 0.1, 0.07498942093324558, 0.05623413251903491, 0.042169650342858224, 0.03162277660168379, 0.023713737056616554, 0.01778279410038923, 0.01333521432163324, 0.01, 0.007498942093324558, 0.005623413251903491, 0.004216965034285823, 0.0031622776601683794, 0.0023713737056616554, 0.0017782794100389228, 0.001333521432163324, 0.001, 0.0007498942093324559, 0.0005623413251903491, 0.00042169650342858224, 0.00031622776601683794, 0.00023713737056616554, 0.00017782794100389227, 0.0001333521432163324};

struct Args { const void* in[27]; float* out; unsigned char* ws; int ph_lo, ph_hi; };

#define XB_TMO      128
#define XB_XCNT(j)  (256  + 64 * (j))
#define XB_XSUB(j)  (1280 + 64 * (j))
#define XB_XGEN(j)  (2304 + 64 * (j))
#define XB_TOP      3328
#define XB_TOPGEN   3392
#define XCD_BAR_WORDS 3456
#define XB_SPIN_CAP (1u << 18)

__device__ __forceinline__ unsigned xb_ld(unsigned* p)              { return __hip_atomic_load(p, __ATOMIC_RELAXED, __HIP_MEMORY_SCOPE_AGENT); }
__device__ __forceinline__ unsigned xb_add(unsigned* p, unsigned v) { return __hip_atomic_fetch_add(p, v, __ATOMIC_RELAXED, __HIP_MEMORY_SCOPE_AGENT); }
__device__ __forceinline__ unsigned xb_xcc_id() { return (unsigned)__builtin_amdgcn_s_getreg((3 << 11) | 20) & 0xFu; }
#define XB_SPIN(cond, bar) do { unsigned _sp = 0; while (cond) { __builtin_amdgcn_s_sleep(1); \
    if ((++_sp & 255u) == 0u) { if (xb_ld(&(bar)[XB_TMO])) break; if (_sp > XB_SPIN_CAP) { atomicAdd(&(bar)[XB_TMO], 1u); break; } } } } while (0)

struct XcdBarrier {
    unsigned* bar; unsigned x;
    volatile LAS unsigned* st;
};

__device__ __forceinline__ XcdBarrier xcd_barrier_post(unsigned* bar, volatile LAS unsigned* st) {
    XcdBarrier b; b.bar = bar; b.x = xb_xcc_id(); b.st = st;
    if (threadIdx.x == 0) (void)xb_add(&bar[XB_XCNT(b.x)], 1u);
    return b;
}
__device__ __forceinline__ void xcd_barrier_complete(unsigned* bar, unsigned x, unsigned& nloc, unsigned& nx) {
    const unsigned G = gridDim.x * gridDim.y * gridDim.z;
    unsigned sum, cnt, mine, sp = 0u;
    for (;;) {
        sum = 0u; cnt = 0u; mine = 0u;
#pragma unroll
        for (unsigned j = 0; j < 16; ++j) { const unsigned c = xb_ld(&bar[XB_XCNT(j)]); sum += c; cnt += (c > 0u) ? 1u : 0u; mine = (j == x) ? c : mine; }
        if (sum == G) break;
        __builtin_amdgcn_s_sleep(1);
        if ((++sp & 255u) == 0u) { if (xb_ld(&bar[XB_TMO])) break; if (sp > XB_SPIN_CAP) { atomicAdd(&bar[XB_TMO], 1u); break; } }
    }
    nloc = mine > 0u ? mine : 1u; nx = cnt > 0u ? cnt : 1u;
}

__device__ __forceinline__ void xcd_barrier(const XcdBarrier& b) {
    asm volatile("s_waitcnt vmcnt(0)" ::: "memory");
    __syncthreads();
    if (threadIdx.x == 0) {
        unsigned* bar = b.bar;
        __builtin_amdgcn_s_waitcnt(0);
        unsigned nloc = b.st[0], nx = b.st[1];
        if (nloc == 0u) { xcd_barrier_complete(bar, b.x, nloc, nx); b.st[0] = nloc; b.st[1] = nx; }
        const unsigned old = xb_add(&bar[XB_XSUB(b.x)], 1u);
        const unsigned gen = old / nloc;
        if (old + 1u == (gen + 1u) * nloc) {
            __builtin_amdgcn_fence(__ATOMIC_RELEASE, "agent");
            asm volatile("s_waitcnt vmcnt(0)" ::: "memory");
            const unsigned og = xb_add(&bar[XB_TOP], 1u);
            const unsigned tg = og / nx;
            if (og + 1u == (tg + 1u) * nx) xb_add(&bar[XB_TOPGEN], 1u);
            else XB_SPIN(xb_ld(&bar[XB_TOPGEN]) == tg, bar);
            __builtin_amdgcn_fence(__ATOMIC_ACQUIRE, "agent");
            xb_add(&bar[XB_XGEN(b.x)], 1u);
            asm volatile("s_waitcnt vmcnt(0)" ::: "memory");
        } else {
            XB_SPIN(xb_ld(&bar[XB_XGEN(b.x)]) == gen, bar);
            __builtin_amdgcn_fence(__ATOMIC_ACQUIRE, "agent");
            asm volatile("s_waitcnt vmcnt(0)" ::: "memory");
        }
    }
    __syncthreads();
}

__device__ __forceinline__ int dst_row(int mode, int row_off, int n) {
    if (mode == 1 || mode == 2) return (n >> 7) * 256 + (mode == 2 ? 128 : 0) + (n & 127);
    if (mode == 3 && n < 2048) return (n >> 8) * 256 + ((n >> 5) & 1) * 128 + ((n >> 6) & 3) * 32 + (n & 31);
    return row_off + n;
}
struct TJob { const float* W; const float* g1; const float* g2; bf16* WT; int K, N, row_off, mode, item; };
__device__ __forceinline__ unsigned cvtpk_hw(float lo, float hi) { unsigned r; asm volatile("v_cvt_pk_bf16_f32 %0, %1, %2" : "=v"(r) : "v"(lo), "v"(hi)); return r; }
__device__ __forceinline__ void tr_load(const TJob& j, f32x4 (&v)[16], float (&gs)[16], int lane) {
    const int nblk = j.N / 64, nb = j.item % nblk, kb = (j.item / nblk + nb) % (j.K / 64), k0 = 64 * kb, n0 = 64 * nb;
    const float* gain = j.g1; if (j.g2 && k0 >= 1024) gain = j.g2 - 1024;
    const int kl = lane >> 4, n4 = (lane & 15) * 4;
#pragma unroll
    for (int i = 0; i < 16; ++i) v[i] = *(const f32x4*)(j.W + (size_t)(k0 + 4 * i + kl) * j.N + n0 + n4);
#pragma unroll
    for (int i = 0; i < 16; ++i) gs[i] = gain ? gain[k0 + 4 * i + kl] : 1.0f;
}
__device__ __forceinline__ void tr_store(const TJob& j, const f32x4 (&v)[16], const float (&gs)[16], LAS float* scr, int lane) {
    const int nblk = j.N / 64, nb = j.item % nblk, kb = (j.item / nblk + nb) % (j.K / 64), k0 = 64 * kb, n0 = 64 * nb;
    const int kl = lane >> 4, n4 = (lane & 15) * 4;
#pragma unroll
    for (int i = 0; i < 16; ++i) { const int k = 4 * i + kl; *(LAS f32x4*)(scr + k * 68 + (n4 ^ (((k >> 3) & 7) << 2))) = v[i] * gs[i]; }
    LDS_WAIT(); asm volatile("" ::: "memory");
    const int c = lane & 7, nn = lane >> 3;
#pragma unroll
    for (int jj = 0; jj < 8; ++jj) { const int n = nn + 8 * jj; const LAS float* sp = scr + (8 * c) * 68 + (n ^ (c << 2));
        v4u o; o.x = cvtpk_hw(sp[0 * 68], sp[1 * 68]); o.y = cvtpk_hw(sp[2 * 68], sp[3 * 68]); o.z = cvtpk_hw(sp[4 * 68], sp[5 * 68]); o.w = cvtpk_hw(sp[6 * 68], sp[7 * 68]);
        *(v4u*)(j.WT + (size_t)dst_row(j.mode, j.row_off, n0 + n) * j.K + k0 + 8 * c) = o; }
    LDS_WAIT(); asm volatile("" ::: "memory");
}

__device__ __forceinline__ void attn_naive(LAS unsigned char* lds, const bf16* Q, const bf16* K, const bf16* V, bf16* MIXED, float* ss_a, int gw, int NGW, int wave, int lane) {
    LAS float* qs = (LAS float*)lds + wave * 64;
    for (int wu = gw; wu < S_ * 16; wu += NGW) {
        const int t = wu >> 4, h = wu & 15;
        qs[lane] = bf2f(Q[(size_t)t * AW + h * 64 + lane]);
        LDS_WAIT(); asm volatile("" ::: "memory");
        float sc[9];
#pragma unroll
        for (int b = 0; b < 3; ++b)
#pragma unroll
            for (int p = 0; p < 3; ++p) {
                const int diff = 64 * p + lane, kt = t - (diff << (2 * b)); const bool valid = (diff <= 128) && (kt >= 0);
                float dot = 0.f;
                if (valid) { const bf16x8* kr = (const bf16x8*)(K + (size_t)kt * AW + h * 64);
#pragma unroll
                    for (int c = 0; c < 8; ++c) { const bf16x8 kv = kr[c];
#pragma unroll
                        for (int e = 0; e < 8; ++e) dot += qs[8 * c + e] * bf2f((unsigned short)kv[e]); } }
                sc[b * 3 + p] = valid ? dot * 0.125f : -INFINITY;
            }
        float m = sc[0];
#pragma unroll
        for (int i = 1; i < 9; ++i) m = fmaxf(m, sc[i]);
        m = wave_max(m);
        float l = 0.f;
#pragma unroll
        for (int i = 0; i < 9; ++i) { sc[i] = __expf(sc[i] - m); l += sc[i]; }
        l = wave_sum(l);
        float o = 0.f;
#pragma unroll
        for (int b = 0; b < 3; ++b)
#pragma unroll
            for (int p = 0; p < 3; ++p) {
                const int pbits = __float_as_int(sc[b * 3 + p]);
                for (int j = 0; j < 64; ++j) { const int diff = 64 * p + j, kt = t - (diff << (2 * b));
                    if (diff <= 128 && kt >= 0) { const float pj = __int_as_float(__builtin_amdgcn_readlane(pbits, j)); o += pj * bf2f(V[(size_t)kt * AW + h * 64 + lane]); } }
            }
        o = o / l;
        MIXED[(size_t)t * DM + h * 64 + lane] = (bf16)f2bf(o);
        const float q = wave_sum(o * o); if (lane == 0) atomicAdd(ss_a + t, q);
        asm volatile("" ::: "memory");
    }
}

__device__ __forceinline__ void sgu_naive(LAS unsigned char* lds, const bf16* U, const bf16* GV, const float* ln_s1, const float* ln_s2, const float* ln_g, const float* ln_b, const float* w_s, const float* b_s,
                                          bf16* MIXED, float* ss_s, int bx, int G, int tid, int lane) {
    LAS float* GT = (LAS float*)lds;
    LAS float* WL = (LAS float*)(lds + 65536);
    for (int unit = bx; unit < 64 * 8; unit += G) {
        const int c = unit >> 3, g = unit & 7;
        for (int idx = tid; idx < 128 * 128; idx += NWAVES * 64) {
            const int j = idx >> 7, d = idx & 127, tok = c * 128 + j, ch = g * 128 + d;
            const float mean = ln_s1[tok] * (1.0f / AW), var = ln_s2[tok] * (1.0f / AW) - mean * mean, rstd = 1.0f / sqrtf(var + 1e-6f);
            GT[idx] = (bf2f(GV[(size_t)tok * AW + ch]) - mean) * rstd * ln_g[ch] + ln_b[ch];
            WL[idx] = (d <= j) ? w_s[(size_t)g * 16384 + idx] : 0.f;
        }
        __syncthreads();
        const int d = tid & 127, iq = tid >> 7;
        for (int ii = 0; ii < 32; ++ii) {
            const int i = iq * 32 + ii; float acc = 0.f;
            for (int j = 0; j <= i; ++j) acc += WL[i * 128 + j] * GT[j * 128 + d];
            const int tok = c * 128 + i; const float sv = acc + b_s[g * 128 + i];
            const float o = bf2f(U[(size_t)tok * AW + g * 128 + d]) * sv;
            MIXED[(size_t)tok * DM + AW + g * 128 + d] = (bf16)f2bf(o);
            const float q = wave_sum(o * o); if (lane == 0) atomicAdd(ss_s + tok, q);
        }
        __syncthreads();
    }
}

__device__ __forceinline__ void xattn_naive(LAS unsigned char* lds, const bf16* QM, const bf16* KVM, bf16* OM, int gw, int NGW, int wave, int lane) {
    LAS float* qs = (LAS float*)lds + wave * 512;
    for (int wu = gw; wu < S_ * 4; wu += NGW) {
        const int t = wu >> 2, h = wu & 3;
        { const bf16x8 qv = *(const bf16x8*)(QM + (size_t)t * DM + h * 512 + lane * 8);
#pragma unroll
          for (int e = 0; e < 8; ++e) qs[lane * 8 + e] = bf2f((unsigned short)qv[e]); }
        LDS_WAIT(); asm volatile("" ::: "memory");
        float sc[4];
#pragma unroll
        for (int p = 0; p < 4; ++p) {
            const bf16x8* kr = (const bf16x8*)(KVM + (size_t)(64 * p + lane) * (2 * DM) + h * 512); float dot = 0.f;
            for (int c = 0; c < 64; ++c) { const bf16x8 kv = kr[c];
#pragma unroll
                for (int e = 0; e < 8; ++e) dot += qs[8 * c + e] * bf2f((unsigned short)kv[e]); }
            sc[p] = dot * 0.044194173824159216f;
        }
        float m = wave_max(fmaxf(fmaxf(sc[0], sc[1]), fmaxf(sc[2], sc[3])));
        float l = 0.f;
#pragma unroll
        for (int p = 0; p < 4; ++p) { sc[p] = __expf(sc[p] - m); l += sc[p]; }
        l = wave_sum(l);
        float o[8];
#pragma unroll
        for (int e = 0; e < 8; ++e) o[e] = 0.f;
#pragma unroll
        for (int p = 0; p < 4; ++p) { const int pbits = __float_as_int(sc[p]);
            for (int j = 0; j < 64; ++j) { const float pj = __int_as_float(__builtin_amdgcn_readlane(pbits, j));
                const bf16x8 vv = *(const bf16x8*)(KVM + (size_t)(64 * p + j) * (2 * DM) + DM + h * 512 + lane * 8);
#pragma unroll
                for (int e = 0; e < 8; ++e) o[e] += pj * bf2f((unsigned short)vv[e]); } }
        const float il = 1.0f / l;
        v4u w; w.x = pk2(o[0] * il, o[1] * il); w.y = pk2(o[2] * il, o[3] * il); w.z = pk2(o[4] * il, o[5] * il); w.w = pk2(o[6] * il, o[7] * il);
        *(v4u*)(OM + (size_t)t * DM + h * 512 + lane * 8) = w;
        asm volatile("" ::: "memory");
    }
}

typedef short v4s __attribute__((ext_vector_type(4)));
__device__ __forceinline__ v4s tr_read8(LAS unsigned char* p) { return __builtin_amdgcn_ds_read_tr16_b64_v4i16((LAS v4s*)p); }
__device__ __forceinline__ bf16x8 join8(v4s lo, v4s hi) { return (bf16x8){lo[0], lo[1], lo[2], lo[3], hi[0], hi[1], hi[2], hi[3]}; }
__device__ __forceinline__ unsigned cvtpk(float lo, float hi) { unsigned r; asm volatile("v_cvt_pk_bf16_f32 %0, %1, %2" : "=v"(r) : "v"(lo), "v"(hi)); return r; }
__device__ __forceinline__ bf16x8 packP(const f32x4 a, const f32x4 b) { v4u w; w.x = cvtpk(a[0], a[1]); w.y = cvtpk(a[2], a[3]); w.z = cvtpk(b[0], b[1]); w.w = cvtpk(b[2], b[3]); return __builtin_bit_cast(bf16x8, w); }
#define MFMA16(a, b, c) __builtin_amdgcn_mfma_f32_16x16x32_bf16((a), (b), (c), 0, 0, 0)
constexpr int KV_PB = 144, KV_TILE = 256 * KV_PB;

__device__ __forceinline__ void dattn_mfma(LAS unsigned char* lds, const bf16* Q, const bf16* K, const bf16* V, bf16* OB, float* LSE, int bx, int G, int tid, int wave, int lane) {
    asm volatile("" : "+v"(tid), "+v"(lane), "+s"(wave), "+s"(bx));
    const int g = lane >> 4, i16 = lane & 15, q4 = i16 >> 2, p4 = lane & 3;
    LAS unsigned char* Ks = lds; LAS unsigned char* Vs = lds + KV_TILE;
    LAS unsigned char* kbase = Ks + (16 * wave + i16) * KV_PB + g * 16; LAS unsigned char* vbase = Vs + (16 * wave + 4 * g + q4) * KV_PB + p4 * 8;
    const int kj0 = 16 * wave + 4 * g, dl0 = i16 - 4 * g;
    constexpr int NU = 3 * 16 * 64;
    v4u kreg[4], vreg[4]; bf16x8 qn0, qn1;
#define DA_DECODE(u, b, h, r, n, dsh) const int b = (u) >> 10, h = (u) & 15, dsh = 2 * b, r = (((u) & 1023) >> 4) & ((1 << dsh) - 1), n = (((u) & 1023) >> 4) >> dsh
#define DA_GLOAD(u) do { DA_DECODE(u, b_, h_, r_, n_, dsh_); (void)b_; _Pragma("unroll") for (int i = 0; i < 4; ++i) { const int id = tid + 512 * i, row = id >> 3, ch = id & 7, s = 128 * (n_ - 1) + row; \
        if (s >= 0) { const size_t off = ((size_t)r_ + ((size_t)s << dsh_)) * AW + h_ * 64 + ch * 8; kreg[i] = *(const v4u*)(K + off); vreg[i] = *(const v4u*)(V + off); } \
        else { kreg[i] = (v4u){0u, 0u, 0u, 0u}; vreg[i] = (v4u){0u, 0u, 0u, 0u}; } } \
        { const size_t qt_ = (size_t)r_ + ((size_t)(128 * n_ + 16 * wave + i16) << dsh_); qn0 = *(const bf16x8*)(Q + qt_ * AW + h_ * 64 + 8 * g); qn1 = *(const bf16x8*)(Q + qt_ * AW + h_ * 64 + 32 + 8 * g); } } while (0)
    int u = bx;
    if (u < NU) DA_GLOAD(u);
    for (; u < NU; u += G) {
#pragma unroll
        for (int i = 0; i < 4; ++i) { const int id = tid + 512 * i, row = id >> 3, ch = id & 7; *(LAS v4u*)(Ks + row * KV_PB + ch * 16) = kreg[i]; *(LAS v4u*)(Vs + row * KV_PB + ch * 16) = vreg[i]; }
        const bf16x8 qf0 = qn0, qf1 = qn1;
        __syncthreads();
        if (u + G < NU) DA_GLOAD(u + G);
        DA_DECODE(u, b, h, r, n, dsh);
        const int qi = 16 * wave + i16;
        const size_t qtok = (size_t)r + ((size_t)(128 * n + qi) << dsh);
        f32x4 s[9];
#pragma unroll
        for (int t = 0; t < 9; ++t) { LAS unsigned char* kp = kbase + t * (16 * KV_PB);
            const bf16x8 k0 = *(LAS bf16x8*)kp, k1 = *(LAS bf16x8*)(kp + 64);
            s[t] = MFMA16(k0, qf0, ((f32x4){0.f, 0.f, 0.f, 0.f})); s[t] = MFMA16(k1, qf1, s[t]); }
        float mx = -INFINITY;
#pragma unroll
        for (int t = 0; t < 9; ++t)
#pragma unroll
            for (int e = 0; e < 4; ++e) { const int kj = kj0 + (16 * t + e), diff = dl0 + (128 - 16 * t - e); const bool valid = (diff >= 0) && (diff <= 128) && (n > 0 || kj >= 128);
                const float v = valid ? s[t][e] * (0.125f * 1.4426950408889634f) : -INFINITY; s[t][e] = v; mx = fmaxf(mx, v); }
        mx = fmaxf(mx, __shfl_xor(mx, 16)); mx = fmaxf(mx, __shfl_xor(mx, 32));
        float l = 0.f;
#pragma unroll
        for (int t = 0; t < 9; ++t)
#pragma unroll
            for (int e = 0; e < 4; ++e) { const float p = __builtin_amdgcn_exp2f(s[t][e] - mx); s[t][e] = p; l += p; }
        l += __shfl_xor(l, 16); l += __shfl_xor(l, 32);
        f32x4 o[4];
#pragma unroll
        for (int dt = 0; dt < 4; ++dt) o[dt] = (f32x4){0.f, 0.f, 0.f, 0.f};
#pragma unroll
        for (int c = 0; c < 5; ++c) {
            const bf16x8 pf = packP(s[2 * c], (2 * c + 1 < 9) ? s[(2 * c + 1 < 9) ? 2 * c + 1 : 8] : (f32x4){0.f, 0.f, 0.f, 0.f});
            LAS unsigned char* va = vbase + (2 * c) * (16 * KV_PB); LAS unsigned char* vb = vbase + ((2 * c + 1 < 9) ? (2 * c + 1) : (2 * c)) * (16 * KV_PB);
#pragma unroll
            for (int dt = 0; dt < 4; ++dt) { const v4s lo = tr_read8(va + dt * 32), hi = tr_read8(vb + dt * 32); o[dt] = MFMA16(join8(lo, hi), pf, o[dt]); }
        }
        const float il = 1.0f / l;
        bf16* op = OB + ((size_t)b * S_ + qtok) * AW + h * 64 + 4 * g;
#pragma unroll
        for (int dt = 0; dt < 4; ++dt) { v2u w; w.x = cvtpk(o[dt][0] * il, o[dt][1] * il); w.y = cvtpk(o[dt][2] * il, o[dt][3] * il); *(v2u*)(op + 16 * dt) = w; }
        if (g == 0) LSE[((size_t)b * S_ + qtok) * 16 + h] = mx + __builtin_amdgcn_logf(l);
        __syncthreads();
    }
#undef DA_DECODE
#undef DA_GLOAD
}

__device__ __forceinline__ void sgu_mfma(LAS unsigned char* lds, const bf16* U, const bf16* GV, const float* ln_s1, const float* ln_s2, const float* ln_g, const float* ln_b, const float* w_s, const float* b_s,
                                         bf16* MIXED, float* ss_s, int bx, int G, int tid, int wave, int lane) {
    asm volatile("" : "+v"(tid), "+v"(lane), "+s"(wave), "+s"(bx));
    const int g = lane >> 4, i16 = lane & 15, q4 = i16 >> 2, p4 = lane & 3;
    constexpr int PB = 272;
    LAS unsigned char* GN = lds; LAS unsigned char* WS = lds + 128 * PB;
    LAS unsigned char* gbase = GN + (8 * g + q4) * PB + (16 * wave + 4 * p4) * 2; LAS unsigned char* wbase = WS + i16 * PB + (8 * g) * 2;
    for (int unit = bx; unit < 64 * 8; unit += G) {
        const int c = unit >> 3, grp = unit & 7;
#pragma unroll
        for (int k = 0; k < 4; ++k) { const int id = tid + 512 * k, j = id >> 4, ch = id & 15, tok = c * 128 + j;
            const bf16x8 gv = *(const bf16x8*)(GV + (size_t)tok * AW + grp * 128 + 8 * ch);
            const float mean = ln_s1[tok] * (1.0f / AW), var = ln_s2[tok] * (1.0f / AW) - mean * mean, rstd = 1.0f / sqrtf(var + 1e-6f);
            const f32x4 lg0 = *(const f32x4*)(ln_g + grp * 128 + 8 * ch), lg1 = *(const f32x4*)(ln_g + grp * 128 + 8 * ch + 4), lb0 = *(const f32x4*)(ln_b + grp * 128 + 8 * ch), lb1 = *(const f32x4*)(ln_b + grp * 128 + 8 * ch + 4);
            f32x4 x0, x1;
#pragma unroll
            for (int e = 0; e < 4; ++e) { x0[e] = (bf2f((unsigned short)gv[e]) - mean) * rstd * lg0[e] + lb0[e]; x1[e] = (bf2f((unsigned short)gv[4 + e]) - mean) * rstd * lg1[e] + lb1[e]; }
            *(LAS bf16x8*)(GN + j * PB + ch * 16) = packP(x0, x1);
            f32x4 w0 = *(const f32x4*)(w_s + (size_t)grp * 16384 + j * 128 + 8 * ch), w1 = *(const f32x4*)(w_s + (size_t)grp * 16384 + j * 128 + 8 * ch + 4);
#pragma unroll
            for (int e = 0; e < 4; ++e) { if (8 * ch + e > j) w0[e] = 0.f; if (8 * ch + 4 + e > j) w1[e] = 0.f; }
            *(LAS bf16x8*)(WS + j * PB + ch * 16) = packP(w0, w1); }
        __syncthreads();
        f32x4 acc[8];
#pragma unroll
        for (int it = 0; it < 8; ++it) acc[it] = (f32x4){0.f, 0.f, 0.f, 0.f};
#pragma unroll
        for (int ks = 0; ks < 4; ++ks) {
            const v4s lo = tr_read8(gbase + (32 * ks) * PB), hi = tr_read8(gbase + (32 * ks + 4) * PB);
            const bf16x8 gf = join8(lo, hi);
#pragma unroll
            for (int it = 0; it < 8; ++it) if (it >= 2 * ks) { const bf16x8 wf = *(LAS bf16x8*)(wbase + (16 * it) * PB + (32 * ks) * 2); acc[it] = MFMA16(gf, wf, acc[it]); }
        }
#pragma unroll
        for (int it = 0; it < 8; ++it) { const int i = 16 * it + i16, tok = c * 128 + i, chn = grp * 128 + 16 * wave + 4 * g; const float bias = b_s[grp * 128 + i];
            const v2u uu = *(const v2u*)(U + (size_t)tok * AW + chn);
            const float o0 = bf2f((unsigned short)(uu.x & 0xffff)) * (acc[it][0] + bias), o1 = bf2f((unsigned short)(uu.x >> 16)) * (acc[it][1] + bias);
            const float o2 = bf2f((unsigned short)(uu.y & 0xffff)) * (acc[it][2] + bias), o3 = bf2f((unsigned short)(uu.y >> 16)) * (acc[it][3] + bias);
            v2u w; w.x = cvtpk(o0, o1); w.y = cvtpk(o2, o3); *(v2u*)(MIXED + (size_t)tok * DM + AW + chn) = w;
            float q = (o0 * o0 + o1 * o1) + (o2 * o2 + o3 * o3); q += __shfl_xor(q, 16); q += __shfl_xor(q, 32);
            if (g == 0) atomicAdd(ss_s + tok, q); }
        __syncthreads();
    }
}

__device__ __forceinline__ void xattn_mfma(LAS unsigned char* lds, const bf16* QM, const bf16* KVM, bf16* OM, int bx, int G, int tid, int wave, int lane) {
    asm volatile("" : "+v"(tid), "+v"(lane), "+s"(wave), "+s"(bx));
    const int g = lane >> 4, i16 = lane & 15, q4 = i16 >> 2, p4 = lane & 3;
    v4u reg[4];
    const int koff = i16 * KV_PB + g * 16, voff = (4 * g + q4) * KV_PB + p4 * 8;
#define XA_GLOAD(c) do { _Pragma("unroll") for (int i = 0; i < 4; ++i) { const int id = tid + 512 * i, row = id >> 3, ch = id & 7; \
        reg[i] = *(const v4u*)(KVM + (size_t)row * (2 * DM) + (((c) >> 3) ? DM : 0) + h * 512 + 64 * ((c) & 7) + ch * 8); } } while (0)
#define XA_WRITE(buf) do { _Pragma("unroll") for (int i = 0; i < 4; ++i) { const int id = tid + 512 * i, row = id >> 3, ch = id & 7; *(LAS v4u*)((buf) + row * KV_PB + ch * 16) = reg[i]; } } while (0)
    for (int unit = bx; unit < 256; unit += G) {
        const int h = unit & 3, qt = unit >> 2;
        const size_t tokq = (size_t)128 * qt + 16 * wave + i16;
        XA_GLOAD(0);
        bf16x8 qf[16];
#pragma unroll
        for (int c = 0; c < 8; ++c) { qf[2 * c] = *(const bf16x8*)(QM + tokq * DM + h * 512 + 64 * c + 8 * g); qf[2 * c + 1] = *(const bf16x8*)(QM + tokq * DM + h * 512 + 64 * c + 32 + 8 * g); }
        XA_WRITE(lds); __syncthreads();
        f32x4 s[16];
#pragma unroll
        for (int kt = 0; kt < 16; ++kt) s[kt] = (f32x4){0.f, 0.f, 0.f, 0.f};
#pragma unroll
        for (int c = 0; c < 8; ++c) {
            XA_GLOAD(c + 1);
            LAS unsigned char* buf = lds + (c & 1) * KV_TILE;
            const bf16x8 qf0 = qf[2 * c], qf1 = qf[2 * c + 1];
#pragma unroll
            for (int kt = 0; kt < 16; ++kt) { LAS unsigned char* kp = buf + koff + kt * (16 * KV_PB);
                const bf16x8 k0 = *(LAS bf16x8*)kp, k1 = *(LAS bf16x8*)(kp + 64); s[kt] = MFMA16(k0, qf0, s[kt]); s[kt] = MFMA16(k1, qf1, s[kt]); }
            XA_WRITE(lds + ((c + 1) & 1) * KV_TILE);
            __syncthreads();
        }
        float mx = -INFINITY;
#pragma unroll
        for (int kt = 0; kt < 16; ++kt)
#pragma unroll
            for (int e = 0; e < 4; ++e) { s[kt][e] *= (0.044194173824159216f * 1.4426950408889634f); mx = fmaxf(mx, s[kt][e]); }
        mx = fmaxf(mx, __shfl_xor(mx, 16)); mx = fmaxf(mx, __shfl_xor(mx, 32));
        float l = 0.f;
#pragma unroll
        for (int kt = 0; kt < 16; ++kt)
#pragma unroll
            for (int e = 0; e < 4; ++e) { const float p = __builtin_amdgcn_exp2f(s[kt][e] - mx); s[kt][e] = p; l += p; }
        l += __shfl_xor(l, 16); l += __shfl_xor(l, 32);
        const float il = 1.0f / l;
        bf16x8 pf[8];
#pragma unroll
        for (int kc = 0; kc < 8; ++kc) pf[kc] = packP(s[2 * kc], s[2 * kc + 1]);
        for (int c = 8; c < 16; ++c) {
            if (c + 1 < 16) XA_GLOAD(c + 1);
            LAS unsigned char* buf = lds + (c & 1) * KV_TILE;
            f32x4 o[4];
#pragma unroll
            for (int dt = 0; dt < 4; ++dt) o[dt] = (f32x4){0.f, 0.f, 0.f, 0.f};
#pragma unroll
            for (int kc = 0; kc < 8; ++kc) { LAS unsigned char* va = buf + voff + kc * (32 * KV_PB); LAS unsigned char* vb = va + 16 * KV_PB;
#pragma unroll
                for (int dt = 0; dt < 4; ++dt) { const v4s lo = tr_read8(va + dt * 32), hi = tr_read8(vb + dt * 32); o[dt] = MFMA16(join8(lo, hi), pf[kc], o[dt]); } }
            bf16* op = OM + tokq * DM + h * 512 + 64 * (c - 8) + 4 * g;
#pragma unroll
            for (int dt = 0; dt < 4; ++dt) { v2u w; w.x = cvtpk(o[dt][0] * il, o[dt][1] * il); w.y = cvtpk(o[dt][2] * il, o[dt][3] * il); *(v2u*)(op + 16 * dt) = w; }
            if (c + 1 < 16) XA_WRITE(lds + ((c + 1) & 1) * KV_TILE);
            __syncthreads();
        }
    }
#undef XA_GLOAD
#undef XA_WRITE
}

__global__ void __launch_bounds__(NWAVES * 64, 2) mega_fwd(Args args) {
    extern __shared__ __attribute__((aligned(16))) unsigned char lds_raw[];
    LAS unsigned char* lds = (LAS unsigned char*)lds_raw;
    cg::grid_group grid = cg::this_grid();
    const int tid = threadIdx.x, lane = tid & 63, wave = __builtin_amdgcn_readfirstlane(tid >> 6);
    const int G = gridDim.x, bx = blockIdx.x;
    unsigned char* ws = args.ws;
    float* SS = (float*)(ws + WS_CTL);
    float* cosT = (float*)(ws + WS_COS); float* sinT = (float*)(ws + WS_SIN);
    bf16* MK = (bf16*)(ws + WS_MK); bf16* KVM = (bf16*)(ws + WS_KVM);
    bf16* WGU1 = (bf16*)(ws + WS_WGU1); bf16* WD1 = (bf16*)(ws + WS_WD1); bf16* WGU2 = (bf16*)(ws + WS_WGU2); bf16* WD2 = (bf16*)(ws + WS_WD2);
    bf16* WIN = (bf16*)(ws + WS_WIN); bf16* WOUT = (bf16*)(ws + WS_WOUT); bf16* WQ = (bf16*)(ws + WS_WQ); bf16* WKV = (bf16*)(ws + WS_WKV); bf16* WO = (bf16*)(ws + WS_WO);
    bf16* XN = (bf16*)(ws + WS_XN); bf16* MIXED = (bf16*)(ws + WS_MIXED); bf16* HB = (bf16*)(ws + WS_ACT);
    bf16* Qb = (bf16*)(ws + WS_Q); bf16* Kb = (bf16*)(ws + WS_K); bf16* Vb = (bf16*)(ws + WS_V); bf16* Ub = (bf16*)(ws + WS_U); bf16* GVb = (bf16*)(ws + WS_GV);
    bf16* OBb = (bf16*)(ws + WS_OB); float* LSEb = (float*)(ws + WS_LSE);
    bf16* QM = (bf16*)(ws + WS_QM); bf16* OM = (bf16*)(ws + WS_OM);
    const float* x = (const float*)args.in[0]; const float* mem = (const float*)args.in[1]; const int* positions = (const int*)args.in[2];
    float* HRES = args.out;
    const int lo = args.ph_lo, hi = args.ph_hi;
#ifndef PMASK
#define PMASK 0xFFFF
#endif
#define IN(k) (lo <= (k) && (k) < hi && ((PMASK >> (k)) & 1))
#ifdef PROBE_LO
#define STAMP(k) do { if (bx == 0 && tid == 0) ((unsigned long long*)(ws + WS_CTL + 512 * 1024))[(k) + 1] = __builtin_amdgcn_s_memrealtime(); } while (0)
#else
#define STAMP(k) do { } while (0)
#endif
#if MEMSET_INIT
#define SEAM(k) do { xcd_barrier(xbar); STAMP(k); } while (0)
#else
#define SEAM(k) do { if ((k) == 0) { grid.sync(); xbar = xcd_barrier_post(barw, MISC); } else { xcd_barrier(xbar); } STAMP(k); } while (0)
#endif
    unsigned* barw = (unsigned*)(ws + WS_CTL + 768 * 1024);
    volatile LAS unsigned* MISC = (volatile LAS unsigned*)(lds + LDS_BYTES - 64);
    if (tid < 2) MISC[tid] = 0u;
    __syncthreads();
    XcdBarrier xbar; xbar.bar = barw; xbar.x = 0; xbar.st = MISC;
#if MEMSET_INIT
    xbar = xcd_barrier_post(barw, MISC);
    if (args.ph_lo > 1000) grid.sync();
#endif
    const int gw = bx * NWAVES + wave, NGW = G * NWAVES;
    const int gt = bx * (NWAVES * 64) + tid, NGT = G * NWAVES * 64;

    STAMP(-1);
#define INF(k) ((const float*)args.in[k])
    constexpr int I_GU = (DM / 64) * (DFF / 64), I_D = (DFF / 64) * (DM / 64), I_IN = (DM / 64) * (DIN / 64), I_SQ = (DM / 64) * (DM / 64);
    const bool split = (G == 256);
    const int tw = (bx - 128) * NWAVES + wave, NTW = 128 * NWAVES;
#define CONV_SCR ((LAS float*)(lds + wave * 17408))
#define JOB_G0(r, J) do { int r_ = (r); if (r_ < I_GU) { J = TJob{INF(4), INF(3), nullptr, WGU1, DM, DFF, 0, 1, r_}; break; } r_ -= I_GU; \
        if (r_ < I_GU) { J = TJob{INF(5), INF(3), nullptr, WGU1, DM, DFF, 0, 2, r_}; break; } r_ -= I_GU; \
        if (r_ < I_IN) { J = TJob{INF(8), INF(7), nullptr, WIN, DM, DIN, 0, 3, r_}; break; } r_ -= I_IN; \
        if (r_ < I_SQ) { J = TJob{INF(19), nullptr, nullptr, WKV, DM, DM, 0, 0, r_}; break; } r_ -= I_SQ; J = TJob{INF(20), nullptr, nullptr, WKV, DM, DM, 2048, 0, r_}; } while (0)
#define JOB_G1(r, J) do { int r_ = (r); if (r_ < I_D) { J = TJob{INF(6), nullptr, nullptr, WD1, DFF, DM, 0, 0, r_}; break; } r_ -= I_D; \
        if (r_ < I_SQ) { J = TJob{INF(15), INF(13), INF(14), WOUT, DM, DM, 0, 0, r_}; break; } r_ -= I_SQ; \
        if (r_ < I_SQ) { J = TJob{INF(18), INF(16), nullptr, WQ, DM, DM, 0, 0, r_}; break; } r_ -= I_SQ; J = TJob{INF(21), nullptr, nullptr, WO, DM, DM, 0, 0, r_}; } while (0)
#define JOB_G3(r, J) do { int r_ = (r); if (r_ < I_GU) { J = TJob{INF(23), INF(22), nullptr, WGU2, DM, DFF, 0, 1, r_}; break; } r_ -= I_GU; J = TJob{INF(24), INF(22), nullptr, WGU2, DM, DFF, 0, 2, r_}; } while (0)
#define JOB_G10(r, J) do { J = TJob{INF(25), nullptr, nullptr, WD2, DFF, DM, 0, 0, (r)}; } while (0)
#define CONV_LOOP(JOBM, total, w0, nw) do { int it_ = (w0); if (it_ < (total)) { TJob jc_, jn_; f32x4 vc_[16], vn_[16]; float gc_[16], gn_[16]; JOBM(it_, jc_); tr_load(jc_, vc_, gc_, lane); \
        for (;;) { const int nx_ = it_ + (nw); const bool more_ = nx_ < (total); if (more_) { JOBM(nx_, jn_); tr_load(jn_, vn_, gn_, lane); } \
            tr_store(jc_, vc_, gc_, CONV_SCR, lane); if (!more_) break; jc_ = jn_; it_ = nx_; \
            _Pragma("unroll") for (int q_ = 0; q_ < 16; ++q_) { vc_[q_] = vn_[q_]; gc_[q_] = gn_[q_]; } } } } while (0)
#define CONV_G0(w0, nw) CONV_LOOP(JOB_G0, 2 * I_GU + I_IN + 2 * I_SQ, w0, nw)
#define CONV_G1(w0, nw) CONV_LOOP(JOB_G1, I_D + 3 * I_SQ, w0, nw)
#define CONV_G3(w0, nw) CONV_LOOP(JOB_G3, 2 * I_GU, w0, nw)
#define CONV_G10(w0, nw) CONV_LOOP(JOB_G10, I_D, w0, nw)
    if (IN(0)) {
        CONV_G0(gw, NGW);
        CONV_G3(gw, NGW);
        if (!split) { CONV_G1(gw, NGW); CONV_G10(gw, NGW); }
        for (int m = gw; m < S_; m += NGW) {
            const f32x4* xr = (const f32x4*)(x + (size_t)m * DM) + lane; float s = 0.f; v2u* o8 = (v2u*)(XN + (size_t)m * DM) + lane;
#pragma unroll
            for (int j = 0; j < 8; ++j) { const f32x4 v = xr[64 * j]; s += (v[0] * v[0] + v[1] * v[1]) + (v[2] * v[2] + v[3] * v[3]); v2u w; w.x = pk2(v[0], v[1]); w.y = pk2(v[2], v[3]); o8[64 * j] = w; }
            s = wave_sum(s); if (lane == 0) SS[SS_X * S_ + m] = s;
        }
        for (int m = gw; m < NMEM; m += NGW) {
            const f32x4* xr = (const f32x4*)(mem + (size_t)m * DM) + lane; const f32x4* gr = (const f32x4*)(INF(17)) + lane; float s = 0.f; f32x4 v[8];
#pragma unroll
            for (int j = 0; j < 8; ++j) { v[j] = xr[64 * j]; s += (v[j][0] * v[j][0] + v[j][1] * v[j][1]) + (v[j][2] * v[j][2] + v[j][3] * v[j][3]); }
            const float rs = 1.0f / sqrtf(wave_sum(s) * (1.0f / DM) + 1e-6f); v2u* o8 = (v2u*)(MK + (size_t)m * DM) + lane;
#pragma unroll
            for (int j = 0; j < 8; ++j) { const f32x4 g = gr[64 * j]; v2u w; w.x = pk2(v[j][0] * rs * g[0], v[j][1] * rs * g[1]); w.y = pk2(v[j][2] * rs * g[2], v[j][3] * rs * g[3]); o8[64 * j] = w; }
        }
#if !MEMSET_INIT
        if (bx == 0) for (int i = tid; i < XCD_BAR_WORDS; i += NWAVES * 64) barw[i] = 0u;
#endif
        for (int i = gt; i < (SS_N - 1) * S_; i += NGT) SS[S_ + i] = 0.f;
        for (int i = gt; i < S_ * 32; i += NGT) {
            const int row = i >> 5, dd = i & 31; const double xx = (double)positions[row] * INVF[dd];
            const double kq = __builtin_rint(xx * 0.6366197723675814);
            double rr = __builtin_fma(-kq, 1.5707963267948966, xx); rr = __builtin_fma(-kq, 6.123233995736766e-17, rr);
            const int q = ((int)kq) & 3; const double r2 = rr * rr;
            double sn = -1.0 / 1307674368000.0; sn = sn * r2 + 1.0 / 6227020800.0; sn = sn * r2 - 1.0 / 39916800.0; sn = sn * r2 + 1.0 / 362880.0; sn = sn * r2 - 1.0 / 5040.0; sn = sn * r2 + 1.0 / 120.0; sn = sn * r2 - 1.0 / 6.0; sn = sn * r2 + 1.0; sn *= rr;
            double cs = 1.0 / 20922789888000.0; cs = cs * r2 - 1.0 / 87178291200.0; cs = cs * r2 + 1.0 / 479001600.0; cs = cs * r2 - 1.0 / 3628800.0; cs = cs * r2 + 1.0 / 40320.0; cs = cs * r2 - 1.0 / 720.0; cs = cs * r2 + 1.0 / 24.0; cs = cs * r2 - 0.5; cs = cs * r2 + 1.0;
            const double sv = (q == 0) ? sn : (q == 1) ? cs : (q == 2) ? -sn : -cs;
            const double cv = (q == 0) ? cs : (q == 1) ? -sn : (q == 2) ? -cs : sn;
            cosT[i] = (float)cv; sinT[i] = (float)sv;
        }
    }
    SEAM(0);

    if (IN(1)) {
        pg8::Gemm g{XN, WGU1, S_, 2 * DFF, DM}; pg8::StaticOrder S; S.init(S_, 2 * DFF, G, bx);
        pg8::EpiSwiglu E{HB, DFF, SS + SS_X * S_, 1.0f / DM};
        pg8::gemm_phase<pg8::EpiSwiglu, pg8::StaticOrder, true, true>(lds, g, S, E);
        if (split && bx >= 128) CONV_G1(tw, NTW);
    }
    SEAM(1);
    if (IN(2)) {
        pg8::Gemm g{HB, WD1, S_, DM, DFF}; pg8::StaticOrder S; S.init(S_, DM, G, bx);
        pg8::EpiResid<false> E{x, HRES, XN, SS + SS_H1 * S_, nullptr, 0.f, 0.5f, nullptr};
        pg8::gemm_phase<pg8::EpiResid<false>, pg8::StaticOrder, true, true>(lds, g, S, E);
    }
    SEAM(2);
    if (IN(3)) {
        { pg8::Gemm g{XN, WIN, S_, DIN, DM}; pg8::StaticOrder S; S.init(S_, DIN, G, bx);
          pg8::EpiWin E{Qb, (size_t)(8u << 20), SS + SS_H1 * S_, 1.0f / DM, cosT, sinT, SS + LN_S1 * S_, SS + LN_S2 * S_};
          pg8::gemm_phase<pg8::EpiWin, pg8::StaticOrder, true, true>(lds, g, S, E); }
        { pg8::Gemm g{MK, WKV, NMEM, 2 * DM, DM}; pg8::StaticOrder S; S.init(NMEM, 2 * DM, G, (bx + G / 2) % G);
          pg8::EpiBf16Scale E{KVM, 2 * DM, nullptr, 0.f};
          pg8::gemm_phase<pg8::EpiBf16Scale, pg8::StaticOrder, true, true>(lds, g, S, E); }
    }
    SEAM(3);
    if (IN(4)) {
#if USE_MFMA_ATTN
        dattn_mfma(lds, Qb, Kb, Vb, OBb, LSEb, bx, G, tid, wave, lane);
#else
        attn_naive(lds, Qb, Kb, Vb, MIXED, SS + SS_A * S_, gw, NGW, wave, lane);
        __syncthreads();
#endif
#if USE_MFMA_SGU
        sgu_mfma(lds, Ub, GVb, SS + LN_S1 * S_, SS + LN_S2 * S_, (const float*)args.in[9], (const float*)args.in[10], (const float*)args.in[11], (const float*)args.in[12], MIXED, SS + SS_S * S_, bx, G, tid, wave, lane);
#else
        sgu_naive(lds, Ub, GVb, SS + LN_S1 * S_, SS + LN_S2 * S_, (const float*)args.in[9], (const float*)args.in[10], (const float*)args.in[11], (const float*)args.in[12], MIXED, SS + SS_S * S_, bx, G, tid, lane);
#endif
    }
    SEAM(4);
    if (IN(5)) {
        for (int m = gw; m < S_; m += NGW) {
            const float rsg = 1.0f / sqrtf(SS[SS_S * S_ + m] * (1.0f / AW) + 1e-6f);
            v4u* p = (v4u*)(MIXED + (size_t)m * DM) + lane;
#if USE_MFMA_ATTN
            float val[2][8]; float ssq = 0.f;
#pragma unroll
            for (int j = 0; j < 2; ++j) { const int c = lane + 64 * j, hh = c >> 3;
                const float l0 = LSEb[((size_t)0 * S_ + m) * 16 + hh], l1 = LSEb[((size_t)1 * S_ + m) * 16 + hh], l2 = LSEb[((size_t)2 * S_ + m) * 16 + hh];
                const float mx = fmaxf(l0, fmaxf(l1, l2)); float w0 = __builtin_amdgcn_exp2f(l0 - mx), w1 = __builtin_amdgcn_exp2f(l1 - mx), w2 = __builtin_amdgcn_exp2f(l2 - mx);
                const float inv = 1.0f / (w0 + w1 + w2); w0 *= inv; w1 *= inv; w2 *= inv;
                const bf16x8 a0 = *(const bf16x8*)(OBb + ((size_t)0 * S_ + m) * AW + 8 * c), a1 = *(const bf16x8*)(OBb + ((size_t)1 * S_ + m) * AW + 8 * c), a2 = *(const bf16x8*)(OBb + ((size_t)2 * S_ + m) * AW + 8 * c);
#pragma unroll
                for (int e = 0; e < 8; ++e) { const float v = w0 * bf2f((unsigned short)a0[e]) + w1 * bf2f((unsigned short)a1[e]) + w2 * bf2f((unsigned short)a2[e]); val[j][e] = v; ssq += v * v; } }
            const float ra = 1.0f / sqrtf(wave_sum(ssq) * (1.0f / AW) + 1e-6f);
#pragma unroll
            for (int j = 0; j < 2; ++j) { v4u w; w.x = pk2(val[j][0] * ra, val[j][1] * ra); w.y = pk2(val[j][2] * ra, val[j][3] * ra); w.z = pk2(val[j][4] * ra, val[j][5] * ra); w.w = pk2(val[j][6] * ra, val[j][7] * ra); p[64 * j] = w; }
#else
            const float ra = 1.0f / sqrtf(SS[SS_A * S_ + m] * (1.0f / AW) + 1e-6f);
#endif
#pragma unroll
            for (int j = (USE_MFMA_ATTN ? 2 : 0); j < 4; ++j) { v4u w = p[64 * j]; const float sc = j < 2 ? ra : rsg;
                w.x = pk2(bf2f((unsigned short)(w.x & 0xffff)) * sc, bf2f((unsigned short)(w.x >> 16)) * sc); w.y = pk2(bf2f((unsigned short)(w.y & 0xffff)) * sc, bf2f((unsigned short)(w.y >> 16)) * sc);
                w.z = pk2(bf2f((unsigned short)(w.z & 0xffff)) * sc, bf2f((unsigned short)(w.z >> 16)) * sc); w.w = pk2(bf2f((unsigned short)(w.w & 0xffff)) * sc, bf2f((unsigned short)(w.w >> 16)) * sc);
                p[64 * j] = w; }
        }
    }
    SEAM(5);
    if (IN(6)) {
        pg8::Gemm g{MIXED, WOUT, S_, DM, DM}; pg8::StaticOrder S; S.init(S_, DM, G, bx);
        pg8::EpiResid<false> E{HRES, HRES, XN, SS + SS_H2 * S_, nullptr, 0.f, 1.0f, nullptr};
        pg8::gemm_phase<pg8::EpiResid<false>, pg8::StaticOrder, true, true>(lds, g, S, E);
    }
    SEAM(6);
    if (IN(7)) {
        pg8::Gemm g{XN, WQ, S_, DM, DM}; pg8::StaticOrder S; S.init(S_, DM, G, bx);
        pg8::EpiBf16Scale E{QM, DM, SS + SS_H2 * S_, 1.0f / DM};
        pg8::gemm_phase<pg8::EpiBf16Scale, pg8::StaticOrder, true, true>(lds, g, S, E);
    }
    SEAM(7);
    if (IN(8)) {
#if USE_MFMA_XATTN
        xattn_mfma(lds, QM, KVM, OM, bx, G, tid, wave, lane);
#else
        xattn_naive(lds, QM, KVM, OM, gw, NGW, wave, lane);
#endif
    }
    SEAM(8);
    if (IN(9)) {
        pg8::Gemm g{OM, WO, S_, DM, DM}; pg8::StaticOrder S; S.init(S_, DM, G, bx);
        pg8::EpiResid<false> E{HRES, HRES, XN, SS + SS_H3 * S_, nullptr, 0.f, 1.0f, nullptr};
        pg8::gemm_phase<pg8::EpiResid<false>, pg8::StaticOrder, true, true>(lds, g, S, E);
    }
    SEAM(9);
    if (IN(10)) {
        pg8::Gemm g{XN, WGU2, S_, 2 * DFF, DM}; pg8::StaticOrder S; S.init(S_, 2 * DFF, G, bx);
        pg8::EpiSwiglu E{HB, DFF, SS + SS_H3 * S_, 1.0f / DM};
        pg8::gemm_phase<pg8::EpiSwiglu, pg8::StaticOrder, true, true>(lds, g, S, E);
        if (split && bx >= 128) CONV_G10(tw, NTW);
    }
    SEAM(10);
    if (IN(11)) {
        pg8::Gemm g{HB, WD2, S_, DM, DFF}; pg8::StaticOrder S; S.init(S_, DM, G, bx);
        pg8::EpiResid<false> E{HRES, HRES, nullptr, SS + SS_H4 * S_, nullptr, 0.f, 0.5f, nullptr};
        pg8::gemm_phase<pg8::EpiResid<false>, pg8::StaticOrder, true, true>(lds, g, S, E);
    }
    SEAM(11);
    if (IN(12)) {
        const float* fg = (const float*)args.in[26];
        for (int m = gw; m < S_; m += NGW) {
            f32x4* xr = (f32x4*)(HRES + (size_t)m * DM) + lane; const f32x4* gr = (const f32x4*)fg + lane;
            const float rs = 1.0f / sqrtf(SS[SS_H4 * S_ + m] * (1.0f / DM) + 1e-6f);
            float pert = 0.f;
#ifdef PROBE_LO
            if (m < 8) { const unsigned long long* ts = (const unsigned long long*)(ws + WS_CTL + 512 * 1024); const float t_us = (float)(ts[PROBE_HI + 1] - ts[PROBE_LO]) * 0.01f; pert = sqrtf(t_us * 1.024e-5f); }
#endif
#pragma unroll
            for (int j = 0; j < 8; ++j) { f32x4 v = xr[64 * j]; const f32x4 g = gr[64 * j]; v = v * rs * g + pert; xr[64 * j] = v; }
        }
    }
#undef IN
#undef SEAM
}

constexpr int NPH = 13;
extern "C" void kernel_launch(void* const* d_in, const int* in_sizes, int n_in, void* d_out, int out_size, void* d_ws, size_t ws_size, hipStream_t stream) {
    static int grid = 0;
    if (grid == 0) {
        if (n_in != 27 || out_size != S_ * DM || ws_size < WS_END) { fprintf(stderr, "kernel_launch: unexpected problem (n_in %d out %d ws %zu)\n", n_in, out_size, ws_size); grid = -1; return; }
        int dev = 0, cus = 0, per_cu = 0;
        hipGetDevice(&dev); hipDeviceGetAttribute(&cus, hipDeviceAttributeMultiprocessorCount, dev);
        hipFuncSetAttribute((const void*)mega_fwd, hipFuncAttributeMaxDynamicSharedMemorySize, LDS_BYTES);
        hipOccupancyMaxActiveBlocksPerMultiprocessor(&per_cu, (const void*)mega_fwd, NWAVES * 64, LDS_BYTES);
        if (per_cu < 1) per_cu = 1;
        (void)hipGetLastError();
        grid = cus * 1;
        fprintf(stderr, "kernel_launch: cus %d per_cu %d grid %d\n", cus, per_cu, grid);
    }
    if (grid < 0) return;
#if MEMSET_INIT
    if (hipMemsetAsync((unsigned char*)d_ws + WS_CTL + 768 * 1024, 0, 16384, stream) != hipSuccess) { fprintf(stderr, "memset failed\n"); return; }
#endif
    Args a{};
    for (int i = 0; i < 27; ++i) a.in[i] = d_in[i];
    a.out = (float*)d_out; a.ws = (unsigned char*)d_ws; a.ph_lo = 0; a.ph_hi = NPH;
    void* kargs[] = {&a};
    hipError_t e = hipLaunchCooperativeKernel((const void*)mega_fwd, dim3(grid), dim3(NWAVES * 64), kargs, LDS_BYTES, stream);
    if (e != hipSuccess) fprintf(stderr, "cooperative launch failed: %s (grid %d)\n", hipGetErrorString(e), grid);
}
```
